# Optimizing an MI355X kernel written in HIP

```python
import math
import jax, jax.numpy as jnp
from jax import lax
import numpy as np

D_MODEL = 1024
BATCH = 16
SEQ = 2048
DEPTH = 1

RW_WIDTH = 512
RW_HEAD = 64
RW_HEADS = RW_WIDTH // RW_HEAD
RW_DECAY_RANK = 64
RW_AAA_RANK = 64
RW_GN_EPS = RW_HEAD * 1e-5
GD_WIDTH = 512
GD_HEAD = 128
GD_HEADS = GD_WIDTH // GD_HEAD
GD_CONV = 4
GD_CHUNK = 64
NORM_EPS = 1e-6

RW_SHIFT_COLS = 3 * RW_WIDTH + RW_DECAY_RANK + RW_AAA_RANK
SPLIT_RW_Z = RW_SHIFT_COLS
SPLIT_GD_QKV = SPLIT_RW_Z + RW_WIDTH
SPLIT_GD_Z = SPLIT_GD_QKV + 3 * GD_WIDTH
SPLIT_GD_BETA = SPLIT_GD_Z + GD_WIDTH
SPLIT_GD_ALPHA = SPLIT_GD_BETA + GD_HEADS
SPLIT_GATES = SPLIT_GD_ALPHA + GD_HEADS
IN_COLS = SPLIT_GATES + 2 * D_MODEL

kernel_name = "rwkv7_gdn_gated_parallel_block"


def rms_norm(x, g, eps=NORM_EPS):
    xf = x.astype(jnp.float32)
    y = xf * lax.rsqrt(jnp.mean(xf * xf, axis=-1, keepdims=True) + eps)
    return (y * g.astype(jnp.float32)).astype(x.dtype)


def l2_normalize(x, eps=1e-12):
    xf = x.astype(jnp.float32)
    return (xf * lax.rsqrt(jnp.sum(xf * xf, axis=-1, keepdims=True) + eps)).astype(x.dtype)


def token_shift(p, mu):
    prev = jnp.pad(p, ((0, 0), (1, 0), (0, 0)))[:, :-1]
    return p + (prev - p) * mu


def causal_depthwise_conv(x, w):
    K, C = w.shape
    return lax.conv_general_dilated(
        x, w[:, None, :].astype(x.dtype), window_strides=(1,), padding=[(K - 1, 0)],
        dimension_numbers=("NWC", "WIO", "NWC"), feature_group_count=C)


def rwkv7_recurrence(r, w, k, v, kk, b):
    f32 = jnp.float32
    B, T, H, N = r.shape

    def step(S, inp):
        r_t, w_t, k_t, v_t, kk_t, b_t = inp
        sa = jnp.einsum("bhvk,bhk->bhv", S, -kk_t)
        S = S * w_t[:, :, None, :] + sa[..., :, None] * b_t[..., None, :] + v_t[..., :, None] * k_t[..., None, :]
        return S, jnp.einsum("bhvk,bhk->bhv", S, r_t)

    xs = tuple(jnp.moveaxis(t.astype(f32), 1, 0) for t in (r, w, k, v, kk, b))
    _, y = lax.scan(step, jnp.zeros((B, H, N, N), f32), xs)
    return jnp.moveaxis(y, 0, 1)


def rwkv7_branch(p_rw, z_rw, mu, w0, w2, a0, a2, k_k, k_a, r_k, gn_w, gn_b):
    B, T, _ = p_rw.shape
    xs = token_shift(p_rw, mu)
    r, k, v, wd, ad = jnp.split(
        xs, [RW_WIDTH, 2 * RW_WIDTH, 3 * RW_WIDTH, 3 * RW_WIDTH + RW_DECAY_RANK], axis=-1)
    log_w = -jax.nn.softplus(-(w0 + jnp.tanh(wd) @ w2)) - 0.5
    decay = jnp.exp(-jnp.exp(log_w.astype(jnp.float32)))
    a = jax.nn.sigmoid(a0 + ad @ a2)
    heads = lambda t: t.reshape(B, T, RW_HEADS, RW_HEAD)
    kk = l2_normalize(heads(k * k_k))
    k = k * (1 + (a - 1) * k_a)
    r_h, k_h, v_h, a_h, w_h = heads(r), heads(k), heads(v), heads(a), heads(decay)
    y = rwkv7_recurrence(r_h, w_h, k_h, v_h, kk, kk * a_h)
    mean = jnp.mean(y, axis=-1, keepdims=True)
    var = jnp.mean(jnp.square(y - mean), axis=-1, keepdims=True)
    y = ((y - mean) * lax.rsqrt(var + RW_GN_EPS)).reshape(B, T, RW_WIDTH) * gn_w + gn_b
    bonus = jnp.sum(r_h * k_h * r_k, axis=-1, keepdims=True) * v_h
    y = (y + bonus.reshape(B, T, RW_WIDTH)).astype(p_rw.dtype)
    return y * jax.nn.silu(z_rw)


def chunk_gated_delta_rule(q, k, v, g, beta):
    f32 = jnp.float32
    B, H, T, D = q.shape
    C = GD_CHUNK
    N = T // C
    chunks = lambda t: t.astype(f32).reshape((B, H, N, C) + t.shape[3:])
    q = chunks(q) * (D ** -0.5)
    k, v = chunks(k), chunks(v)
    g = jnp.cumsum(chunks(g), axis=-1)
    beta = chunks(beta)
    k_beta = k * beta[..., None]
    v_beta = v * beta[..., None]
    causal = jnp.tril(jnp.ones((C, C), bool))
    strict = jnp.tril(jnp.ones((C, C), bool), -1)
    decay = jnp.exp(jnp.where(causal, g[..., :, None] - g[..., None, :], -jnp.inf))
    eye = jnp.eye(C, dtype=f32)
    A = jnp.where(strict, jnp.einsum("bhnid,bhnjd->bhnij", k_beta, k) * decay, 0.0)
    t_inv = lax.linalg.triangular_solve(eye + A, jnp.broadcast_to(eye, A.shape),
                                        left_side=True, lower=True, unit_diagonal=True)
    u = t_inv @ v_beta
    w = t_inv @ (k_beta * jnp.exp(g)[..., None])
    qk = jnp.einsum("bhnid,bhnjd->bhnij", q, k) * decay
    q_decayed = q * jnp.exp(g)[..., None]
    g_last = g[..., -1]
    k_to_end = k * jnp.exp(g_last[..., None] - g)[..., None]

    def step(S, inp):
        qd_c, kte_c, u_c, w_c, qk_c, gl_c = inp
        v_new = u_c - w_c @ S
        o = qd_c @ S + qk_c @ v_new
        S = S * jnp.exp(gl_c)[..., None, None] + jnp.einsum("bhck,bhcv->bhkv", kte_c, v_new)
        return S, o

    xs = tuple(jnp.moveaxis(t, 2, 0) for t in (q_decayed, k_to_end, u, w, qk, g_last))
    _, o = lax.scan(step, jnp.zeros((B, H, D, v.shape[-1]), f32), xs)
    return jnp.moveaxis(o, 0, 2).reshape(B, H, T, -1)


def gdn_branch(qkv, z, beta_logit, alpha, conv_w, A_log, dt_bias, o_norm_w):
    B, T, _ = qkv.shape
    f32 = jnp.float32
    qkv = jax.nn.silu(causal_depthwise_conv(qkv, conv_w))
    q, k, v = jnp.split(qkv, 3, axis=-1)
    heads = lambda t: jnp.swapaxes(t.reshape(B, T, GD_HEADS, GD_HEAD), 1, 2)
    q, k, v = l2_normalize(heads(q)), l2_normalize(heads(k)), heads(v)
    beta = jnp.swapaxes(jax.nn.sigmoid(beta_logit.astype(f32)), 1, 2)
    g = -jnp.exp(A_log.astype(f32)) * jax.nn.softplus(alpha.astype(f32) + dt_bias.astype(f32))
    g = jnp.swapaxes(g, 1, 2)
    o = jnp.swapaxes(chunk_gated_delta_rule(q, k, v, g, beta), 1, 2)
    o = rms_norm(o, o_norm_w) * jax.nn.silu(z.reshape(B, T, GD_HEADS, GD_HEAD).astype(f32))
    return o.reshape(B, T, GD_WIDTH).astype(qkv.dtype)


def setup_inputs(seed: int = 0) -> dict:
    key = jax.random.key(seed)
    ks = jax.random.split(key, 24)
    f32 = jnp.float32
    L = DEPTH
    nrm = lambda k, shape, scale: jax.random.normal(k, shape, f32) * scale
    x = nrm(ks[0], (BATCH, SEQ, D_MODEL), 1.0)
    norm_in_w = 1.0 + nrm(ks[1], (L, D_MODEL), 0.02)
    w_in = nrm(ks[2], (L, D_MODEL, IN_COLS), D_MODEL ** -0.5)
    rw_mu = jax.random.uniform(ks[3], (L, RW_SHIFT_COLS), f32)
    rw_w0 = jax.random.uniform(ks[4], (L, RW_WIDTH), f32, -5.0, 1.0)
    rw_w2 = nrm(ks[5], (L, RW_DECAY_RANK, RW_WIDTH), 0.1)
    rw_a0 = nrm(ks[6], (L, RW_WIDTH), 0.1)
    rw_a2 = nrm(ks[7], (L, RW_AAA_RANK, RW_WIDTH), 0.1)
    rw_k_k = 0.85 + nrm(ks[8], (L, RW_WIDTH), 0.02)
    rw_k_a = 1.0 + nrm(ks[9], (L, RW_WIDTH), 0.02)
    rw_r_k = nrm(ks[10], (L, RW_HEADS, RW_HEAD), 0.1)
    rw_gn_w = 1.0 + nrm(ks[11], (L, RW_WIDTH), 0.02)
    rw_gn_b = nrm(ks[12], (L, RW_WIDTH), 0.02)
    gd_conv_w = nrm(ks[13], (L, GD_CONV, 3 * GD_WIDTH), GD_CONV ** -0.5)
    gd_A_log = jnp.log(jax.random.uniform(ks[14], (L, GD_HEADS), f32, 1.0, 16.0))
    dt = jnp.exp(jax.random.uniform(ks[15], (L, GD_HEADS), f32, math.log(1e-3), math.log(1e-1)))
    gd_dt_bias = dt + jnp.log(-jnp.expm1(-dt))
    gd_o_norm_w = 1.0 + nrm(ks[16], (L, GD_HEAD), 0.02)
    w_branch_a = nrm(ks[17], (L, RW_WIDTH, D_MODEL), RW_WIDTH ** -0.5)
    w_branch_b = nrm(ks[18], (L, GD_WIDTH, D_MODEL), GD_WIDTH ** -0.5)
    w_out = nrm(ks[19], (L, D_MODEL, D_MODEL), D_MODEL ** -0.5)
    norm_out_w = 1.0 + nrm(ks[20], (D_MODEL,), 0.02)
    return {"x": x, "norm_in_w": norm_in_w, "w_in": w_in, "rw_mu": rw_mu, "rw_w0": rw_w0,
            "rw_w2": rw_w2, "rw_a0": rw_a0, "rw_a2": rw_a2, "rw_k_k": rw_k_k, "rw_k_a": rw_k_a,
            "rw_r_k": rw_r_k, "rw_gn_w": rw_gn_w, "rw_gn_b": rw_gn_b, "gd_conv_w": gd_conv_w,
            "gd_A_log": gd_A_log, "gd_dt_bias": gd_dt_bias, "gd_o_norm_w": gd_o_norm_w,
            "w_branch_a": w_branch_a, "w_branch_b": w_branch_b, "w_out": w_out,
            "norm_out_w": norm_out_w}


def reference(x, norm_in_w, w_in, rw_mu, rw_w0, rw_w2, rw_a0, rw_a2, rw_k_k, rw_k_a, rw_r_k,
              rw_gn_w, rw_gn_b, gd_conv_w, gd_A_log, gd_dt_bias, gd_o_norm_w,
              w_branch_a, w_branch_b, w_out, norm_out_w):
    for l in range(DEPTH):
        h = rms_norm(x, norm_in_w[l])
        p = h @ w_in[l]
        p_rw, z_rw, qkv_gd, z_gd, beta_gd, alpha_gd, gates = jnp.split(
            p, [SPLIT_RW_Z, SPLIT_GD_QKV, SPLIT_GD_Z, SPLIT_GD_BETA, SPLIT_GD_ALPHA, SPLIT_GATES],
            axis=-1)
        y_a = rwkv7_branch(p_rw, z_rw, rw_mu[l], rw_w0[l], rw_w2[l], rw_a0[l], rw_a2[l],
                           rw_k_k[l], rw_k_a[l], rw_r_k[l], rw_gn_w[l], rw_gn_b[l])
        y_b = gdn_branch(qkv_gd, z_gd, beta_gd, alpha_gd, gd_conv_w[l], gd_A_log[l],
                         gd_dt_bias[l], gd_o_norm_w[l])
        gate_a, gate_b = jnp.split(gates, 2, axis=-1)
        merged = (jax.nn.sigmoid(gate_a) * (y_a @ w_branch_a[l])
                  + jax.nn.sigmoid(gate_b) * (y_b @ w_branch_b[l]))
        x = x + merged @ w_out[l]
    return rms_norm(x, norm_out_w)
```

```cpp
#include <hip/hip_runtime.h>
#include <hip/hip_cooperative_groups.h>
#include <cstdio>
#include <utility>
namespace cg = cooperative_groups;
namespace pg8 {
#define PG8_LAS __attribute__((address_space(3)))
typedef unsigned short bf16_t;
typedef short bf16x8 __attribute__((ext_vector_type(8)));
typedef float f32x4 __attribute__((ext_vector_type(4)));
typedef unsigned u32x4 __attribute__((ext_vector_type(4)));
constexpr int BM = 256, BK = 64, HALF = 128, HTB = HALF * BK * 2  , STAGE_BYTES = 8 * HTB, NXCD = 8, WGM = 8;

__host__ __device__ __forceinline__ int lds_byte(int r, int c) { const int st = (r >> 4) * 2 + (c >> 5), rr = r & 15, cc = c & 31, ob = rr * 64 + cc * 2; return st * 1024 + (ob ^ (((ob >> 9) & 1) << 5)); }
__host__ __device__ __forceinline__ void stage_rc(int b, int& R, int& C) { const int st = b / 1024, sb = b % 1024, swz = sb ^ (((sb >> 9) & 1) << 5); R = (st >> 1) * 16 + swz / 64; C = (st & 1) * 32 + (swz % 64) / 2; }
__host__ __device__ __forceinline__ int perm32(int rho) { const int n = rho >> 4, i = rho & 15; return 8 * (i >> 2) + 4 * n + (i & 3); }


struct Unit { int pm, pn; };
struct Gemm { const bf16_t* A; const bf16_t* Bt; int M, N, K; const bf16_t* A2; int lda, ksplit; };
struct StaticOrder {
    int nM, nN, nwg, G, c;
    __host__ __device__ void init(int M, int N, int G_, int c_) { nM = M / BM; nN = N / BM; nwg = nM * nN; G = G_; c = c_; }
    __host__ __device__ bool next(int i, Unit& u) const {
        const long L = (long)i * G + c; if (L >= nwg) return false;
        int wgid = (int)L; { const int q = nwg / NXCD, r = nwg % NXCD, xcd = wgid % NXCD, off = wgid / NXCD; wgid = (xcd < r ? xcd * (q + 1) : r * (q + 1) + (xcd - r) * q) + off; }
        const int nig = WGM * nN, gid = wgid / nig, fm = gid * WGM, gsz = (nM - fm) < WGM ? (nM - fm) : WGM;
        u.pm = fm + ((wgid % nig) % gsz); u.pn = (wgid % nig) / gsz; return true;
    }
    __device__ __forceinline__ void a_ready(const Unit&) const {}
    __device__ __forceinline__ void done(const Unit&) const {}
};
__device__ __forceinline__ unsigned cvt_pk_bf16(float lo, float hi) { unsigned r; asm volatile("v_cvt_pk_bf16_f32 %0, %1, %2" : "=v"(r) : "v"(lo), "v"(hi)); return r; }
template <class Epi, class Sched>
__device__ __forceinline__ void gemm_phase(PG8_LAS unsigned char* lds, const Gemm g, const Sched& S, const Epi& E) {
    int tid_ = threadIdx.x; asm volatile("" : "+v"(tid_));
    const int tid = tid_, wid = __builtin_amdgcn_readfirstlane(tid >> 6), lane = tid & 63, wr = wid >> 2, wc = wid & 3, fr = lane & 15, fq = lane >> 4;
    int K_ = g.K; asm volatile("" : "+s"(K_));
    const int K = K_, nt = K / BK;
    const int lda = Epi::SPLIT_A ? g.lda : K, ksplit = Epi::SPLIT_A ? g.ksplit : 0;
    unsigned voffA[2], voffB[2];
#pragma unroll
    for (int i = 0; i < 2; ++i) { int R, C; stage_rc(tid * 16 + i * 8192, R, C); const int Rb = Epi::PERM ? ((R & ~31) + perm32(R & 31)) : R;
        voffA[i] = (unsigned)(R * lda + C) * 2u; voffB[i] = (unsigned)(Rb * K + C) * 2u; }
    const size_t kstep = (size_t)(BK * 2);
    const size_t hstep = (size_t)HALF * K * 2;
    const size_t tstep = 2 * hstep;
    const size_t hstepA = (size_t)HALF * lda * 2, tstepA = 2 * hstepA;
    const unsigned ldsw = (unsigned)wid * 1024u;
    const int aoff = lds_byte(wr * 64 + fr, fq * 8), boff = lds_byte(wc * 32 + fr, fq * 8);
#define PG8_SA(b, h) (((b) * 2 + (h)) * HTB)
#define PG8_SB(b, h) ((4 + (b) * 2 + (h)) * HTB)
#define PG8_STAGE(bufoff, gbase, voff) do { _Pragma("unroll") for (int _i = 0; _i < 2; ++_i) \
        __builtin_amdgcn_global_load_lds((const unsigned*)((const char*)(gbase) + (voff)[_i]), (PG8_LAS unsigned*)(lds + (bufoff) + ldsw + _i * 8192), 16, 0, 0); } while (0)
#define PG8_LDA(dst, b, h) do { _Pragma("unroll") for (int m = 0; m < 4; ++m) _Pragma("unroll") for (int k = 0; k < 2; ++k) dst[m][k] = *(const PG8_LAS bf16x8*)(lds + PG8_SA(b, h) + aoff + m * 2048 + k * 1024); } while (0)
#define PG8_LDB(dst, b, h) do { _Pragma("unroll") for (int n = 0; n < 2; ++n) _Pragma("unroll") for (int k = 0; k < 2; ++k) dst[n][k] = *(const PG8_LAS bf16x8*)(lds + PG8_SB(b, h) + boff + n * 2048 + k * 1024); } while (0)
#define PG8_MMA(ai, bj, At, Bt) do { __builtin_amdgcn_s_setprio(1); _Pragma("unroll") for (int m = 0; m < 4; ++m) _Pragma("unroll") for (int n = 0; n < 2; ++n) _Pragma("unroll") for (int k = 0; k < 2; ++k) \
        acc[ai][bj][m][n] = __builtin_amdgcn_mfma_f32_16x16x32_bf16(Bt[n][k], At[m][k], acc[ai][bj][m][n], 0, 0, 0); __builtin_amdgcn_s_setprio(0); } while (0)
#define PG8_WAIT_V(n) asm volatile("s_waitcnt vmcnt(" #n ")" ::: "memory")
#define PG8_WAIT_L(n) asm volatile("s_waitcnt lgkmcnt(" #n ")" ::: "memory")
#define PG8_BAR __builtin_amdgcn_s_barrier()
#define PG8_SCHED __builtin_amdgcn_sched_barrier(0)
    Unit cur, nxt; int ui = 0;
    if (!S.next(0, cur)) return;
    f32x4 acc[2][2][4][2];
#pragma unroll
    for (int a = 0; a < 2; ++a)
#pragma unroll
        for (int b = 0; b < 2; ++b)
#pragma unroll
            for (int m = 0; m < 4; ++m)
#pragma unroll
                for (int n = 0; n < 2; ++n) acc[a][b][m][n] = (f32x4){0.f, 0.f, 0.f, 0.f};
    bf16x8 At[4][2], B0[2][2], B1[2][2];
    const char* cA = (const char*)g.A + (size_t)cur.pm * tstepA; const char* cB = (const char*)g.Bt + (size_t)cur.pn * tstep;
    const char* cA2 = Epi::SPLIT_A ? (const char*)g.A2 + (size_t)cur.pm * tstepA : cA;
    S.a_ready(cur);
    PG8_STAGE(PG8_SB(0, 0), cB, voffB); PG8_STAGE(PG8_SA(0, 0), cA, voffA); PG8_STAGE(PG8_SB(0, 1), cB + hstep, voffB); PG8_STAGE(PG8_SA(0, 1), cA + hstepA, voffA);
    if (wr == 1) PG8_BAR;
    PG8_WAIT_V(4); PG8_BAR;
    PG8_STAGE(PG8_SB(1, 0), cB + kstep, voffB); PG8_STAGE(PG8_SA(1, 0), cA + kstep, voffA); PG8_STAGE(PG8_SB(1, 1), cB + hstep + kstep, voffB);
    PG8_WAIT_V(6); PG8_BAR;
    for (;;) {
        const bool has_next = S.next(ui + 1, nxt);
        const char* nA = has_next ? (const char*)g.A + (size_t)nxt.pm * tstepA : cA; const char* nB = has_next ? (const char*)g.Bt + (size_t)nxt.pn * tstep : cB;
        const char* nA2 = (Epi::SPLIT_A && has_next) ? (const char*)g.A2 + (size_t)nxt.pm * tstepA : cA2;
        for (int t = 0; t < nt; t += 2) {
            const bool last = (t == nt - 2);
            const char* a1 = (Epi::SPLIT_A && t + 1 >= ksplit) ? cA2 + (size_t)(t + 1 - ksplit) * kstep : cA + (size_t)(t + 1) * kstep;
            const char* a2 = last ? nA : ((Epi::SPLIT_A && t + 2 >= ksplit) ? cA2 + (size_t)(t + 2 - ksplit) * kstep : cA + (size_t)(t + 2) * kstep); const char* b2 = last ? nB : cB + (size_t)(t + 2) * kstep;
            const char* a3 = a2 + kstep; const char* b3 = b2 + kstep;
            if (last && has_next) S.a_ready(nxt);
            if constexpr (Epi::SPLIT_A) { if (t == ksplit) E.mid(acc, cur, wr, wc, fr, fq); }
            PG8_LDB(B0, 0, 0); PG8_SCHED; PG8_LDA(At, 0, 0); PG8_STAGE(PG8_SA(1, 1), a1 + hstepA, voffA);
            PG8_WAIT_L(8); PG8_BAR; PG8_WAIT_L(0); PG8_MMA(0, 0, At, B0); PG8_BAR; PG8_SCHED;
            PG8_LDB(B1, 0, 1); PG8_STAGE(PG8_SB(0, 0), b2, voffB);
            PG8_BAR; PG8_WAIT_L(0); PG8_MMA(0, 1, At, B1); PG8_BAR;
            PG8_LDA(At, 0, 1); PG8_STAGE(PG8_SA(0, 0), a2, voffA);
            PG8_BAR; PG8_WAIT_L(0); PG8_MMA(1, 0, At, B0); PG8_BAR; PG8_SCHED;
            PG8_STAGE(PG8_SB(0, 1), b2 + hstep, voffB);
            PG8_WAIT_V(6); PG8_BAR; PG8_MMA(1, 1, At, B1); PG8_BAR;
            PG8_LDB(B0, 1, 0); PG8_SCHED; PG8_LDA(At, 1, 0); PG8_STAGE(PG8_SA(0, 1), a2 + hstepA, voffA);
            PG8_WAIT_L(8); PG8_BAR; PG8_WAIT_L(0); PG8_MMA(0, 0, At, B0); PG8_BAR; PG8_SCHED;
            PG8_LDB(B1, 1, 1); PG8_STAGE(PG8_SB(1, 0), b3, voffB);
            PG8_BAR; PG8_WAIT_L(0); PG8_MMA(0, 1, At, B1); PG8_BAR;
            PG8_LDA(At, 1, 1); PG8_STAGE(PG8_SA(1, 0), a3, voffA);
            PG8_BAR; PG8_WAIT_L(0); PG8_MMA(1, 0, At, B0); PG8_BAR; PG8_SCHED;
            PG8_STAGE(PG8_SB(1, 1), b3 + hstep, voffB);
            PG8_WAIT_V(6); PG8_BAR; PG8_MMA(1, 1, At, B1); PG8_BAR;
        }
        if constexpr (!Epi::AFTER_DRAIN) { E(acc, cur, wr, wc, fr, fq); S.done(cur); }
        if (!has_next) break;
#pragma unroll
        for (int a = 0; a < 2; ++a)
#pragma unroll
            for (int b = 0; b < 2; ++b)
#pragma unroll
                for (int m = 0; m < 4; ++m)
#pragma unroll
                    for (int n = 0; n < 2; ++n) acc[a][b][m][n] = (f32x4){0.f, 0.f, 0.f, 0.f};
        cur = nxt; cA = nA; cA2 = nA2; cB = nB; ++ui;
    }
    PG8_WAIT_V(0);
    if (wr == 0) PG8_BAR;
    PG8_BAR;
    if constexpr (Epi::AFTER_DRAIN) { E.fused(acc, cur, wr, wc, fr, fq, lds, wid, lane); S.done(cur); }
#undef PG8_SA
#undef PG8_SB
#undef PG8_STAGE
#undef PG8_LDA
#undef PG8_LDB
#undef PG8_MMA
#undef PG8_WAIT_V
#undef PG8_WAIT_L
#undef PG8_BAR
#undef PG8_SCHED
}
}

using pg8::bf16_t; using pg8::f32x4; using pg8::u32x4; using pg8::Unit;
#define LAS __attribute__((address_space(3)))

constexpr int MTOK = 32768, DM = 1024, TSEQ = 2048, NB = 16;
constexpr int INC = 6280, NPAD = 6400;
constexpr int LDS_BYTES = 163840;
constexpr size_t OFF_H    = 0;
constexpr size_t OFF_BT   = OFF_H + 67108864ull;
constexpr size_t OFF_BTIN = OFF_BT;
constexpr size_t OFF_BTA  = OFF_BTIN + 13107200ull;
constexpr size_t OFF_BTB  = OFF_BTA + 1048576ull;
constexpr size_t OFF_BTO  = OFF_BTB + 1048576ull;
constexpr size_t OFF_BTS  = OFF_BTO + 2097152ull;
constexpr size_t OFF_RSS  = OFF_BTS + 524288ull;
constexpr size_t OFF_PRKV = OFF_RSS + 131072ull;
constexpr size_t OFF_PX   = OFF_PRKV + 100663296ull;
constexpr size_t OFF_ZRW  = OFF_PX + 17825792ull;
constexpr size_t OFF_QKV  = OFF_ZRW + 33554432ull;
constexpr size_t OFF_ZGD  = OFF_QKV + 100663296ull;
constexpr size_t OFF_AP   = OFF_ZGD + 33554432ull;
constexpr size_t OFF_AA   = OFF_AP + 16777216ull;
constexpr size_t OFF_GQKV = OFF_AA + 33554432ull;
constexpr size_t OFF_BAR  = OFF_GQKV + 100663296ull;
constexpr size_t WS_END   = OFF_BAR + 16384ull;

struct Params {
    const float *x, *norm_in_w, *w_in, *rw_mu, *rw_w0, *rw_w2, *rw_a0, *rw_a2, *rw_k_k, *rw_k_a, *rw_r_k, *rw_gn_w, *rw_gn_b,
                *gd_conv_w, *gd_A_log, *gd_dt_bias, *gd_o_norm_w, *w_branch_a, *w_branch_b, *w_out, *norm_out_w;
    float* out; unsigned char* ws;
    int pad0, pad1;
};

__device__ __forceinline__ int otid() { int t = threadIdx.x; asm volatile("" : "+v"(t)); return t; }
__device__ __forceinline__ float bf2f(bf16_t v) { return __uint_as_float(((unsigned)v) << 16); }
__device__ __forceinline__ bf16_t f2bf(float f) { unsigned u = __float_as_uint(f); u += 0x7FFFu + ((u >> 16) & 1u); return (bf16_t)(u >> 16); }
__device__ __forceinline__ unsigned pk2(float lo, float hi) { return pg8::cvt_pk_bf16(lo, hi); }
__device__ __forceinline__ float wave_sum(float v) {
    v += __int_as_float(__builtin_amdgcn_update_dpp(0, __float_as_int(v), 0xB1, 0xF, 0xF, true));
    v += __int_as_float(__builtin_amdgcn_update_dpp(0, __float_as_int(v), 0x4E, 0xF, 0xF, true));
    v += __int_as_float(__builtin_amdgcn_update_dpp(0, __float_as_int(v), 0x141, 0xF, 0xF, true));
    v += __int_as_float(__builtin_amdgcn_update_dpp(0, __float_as_int(v), 0x140, 0xF, 0xF, true));
    const int iv = __float_as_int(v);
    return (__int_as_float(__builtin_amdgcn_readlane(iv, 0)) + __int_as_float(__builtin_amdgcn_readlane(iv, 16))) + (__int_as_float(__builtin_amdgcn_readlane(iv, 32)) + __int_as_float(__builtin_amdgcn_readlane(iv, 48)));
}
__device__ __forceinline__ float row_sum16(float v) {
    v += __int_as_float(__builtin_amdgcn_update_dpp(0, __float_as_int(v), 0xB1, 0xF, 0xF, true));
    v += __int_as_float(__builtin_amdgcn_update_dpp(0, __float_as_int(v), 0x4E, 0xF, 0xF, true));
    v += __int_as_float(__builtin_amdgcn_update_dpp(0, __float_as_int(v), 0x141, 0xF, 0xF, true));
    v += __int_as_float(__builtin_amdgcn_update_dpp(0, __float_as_int(v), 0x140, 0xF, 0xF, true));
    return v;
}
#define LD4(ptr) (*(const f32x4*)(ptr))
#define PIN() asm volatile("" ::: "memory")
__device__ __forceinline__ float sigmoidf_(float v) { return __builtin_amdgcn_rcpf(1.f + __expf(-v)); }
__device__ __forceinline__ float softplusf_(float v) { return fmaxf(v, 0.f) + log1pf(__expf(-fabsf(v))); }
__device__ __forceinline__ void unpack8(const u32x4 w, float (&f)[8]) {
    f[0] = __uint_as_float(w.x << 16); f[1] = __uint_as_float(w.x & 0xffff0000u); f[2] = __uint_as_float(w.y << 16); f[3] = __uint_as_float(w.y & 0xffff0000u);
    f[4] = __uint_as_float(w.z << 16); f[5] = __uint_as_float(w.z & 0xffff0000u); f[6] = __uint_as_float(w.w << 16); f[7] = __uint_as_float(w.w & 0xffff0000u);
}
__device__ __forceinline__ u32x4 pack8(const float (&f)[8]) { u32x4 w; w.x = pk2(f[0], f[1]); w.y = pk2(f[2], f[3]); w.z = pk2(f[4], f[5]); w.w = pk2(f[6], f[7]); return w; }


#define EPI_LOOP(...) \
    const int row0 = u.pm * 256 + wr * 64 + fr, col0 = u.pn * 256 + wc * 32 + 8 * fq; \
    _Pragma("unroll") for (int ai = 0; ai < 2; ++ai) _Pragma("unroll") for (int m = 0; m < 4; ++m) _Pragma("unroll") for (int bj = 0; bj < 2; ++bj) { \
        const int row = row0 + ai * 128 + m * 16, col = col0 + bj * 128; \
        const float v[8] = {acc[ai][bj][m][0][0], acc[ai][bj][m][0][1], acc[ai][bj][m][0][2], acc[ai][bj][m][0][3], acc[ai][bj][m][1][0], acc[ai][bj][m][1][1], acc[ai][bj][m][1][2], acc[ai][bj][m][1][3]}; \
        __VA_ARGS__ }
struct EpiIn {
    static constexpr bool PERM = true, AFTER_DRAIN = false, SPLIT_A = false;
    unsigned char* ws; float* gates;
    __device__ __forceinline__ void operator()(const f32x4 (&acc)[2][2][4][2], const Unit& u, int wr, int wc, int fr, int fq) const {
        const int pn = u.pn;
        if (pn == 6) {
            float* base = (float*)(ws + OFF_PX);
            EPI_LOOP( const int c = col - 1536; if (c < 136) { float* d = base + (size_t)row * 136 + c; *(f32x4*)d = (f32x4){v[0], v[1], v[2], v[3]}; *(f32x4*)(d + 4) = (f32x4){v[4], v[5], v[6], v[7]}; } )
        } else {
            bf16_t* base; int ld, coff;
            if (pn < 6) { base = (bf16_t*)(ws + OFF_PRKV); ld = 1536; coff = 0; }
            else if (pn < 9) { base = (bf16_t*)(ws + OFF_ZRW); ld = 512; coff = 1792; }
            else if (pn < 15) { base = (bf16_t*)(ws + OFF_QKV); ld = 1536; coff = 2304; }
            else if (pn < 17) { base = (bf16_t*)(ws + OFF_ZGD); ld = 512; coff = 3840; }
            else { base = (bf16_t*)gates; ld = 2048; coff = 4352; }
            EPI_LOOP( *(u32x4*)(base + (size_t)row * ld + (col - coff)) = pack8(v); )
        }
    }
};
struct EpiSmall {
    static constexpr bool PERM = true, AFTER_DRAIN = false, SPLIT_A = false;
    unsigned char* ws;
    __device__ __forceinline__ void operator()(const f32x4 (&acc)[2][2][4][2], const Unit& u, int wr, int wc, int fr, int fq) const {
        if (u.pn < 2) {
            float* base = (float*)(ws + OFF_H);
            EPI_LOOP( float* d = base + (size_t)row * 512 + col; *(f32x4*)d = (f32x4){v[0], v[1], v[2], v[3]}; *(f32x4*)(d + 4) = (f32x4){v[4], v[5], v[6], v[7]}; )
        } else {
            bf16_t* base = (bf16_t*)(ws + OFF_AA);
            EPI_LOOP( *(u32x4*)(base + (size_t)row * 512 + (col - 512)) = pack8(v); )
        }
    }
};
struct EpiC1 {
    static constexpr bool PERM = true, AFTER_DRAIN = false, SPLIT_A = false;
    unsigned char* ws; const float* gates;
    __device__ __forceinline__ void operator()(const f32x4 (&acc)[2][2][4][2], const Unit& u, int wr, int wc, int fr, int fq) const {
        const bf16_t* gb = (const bf16_t*)gates; bf16_t* m1b = (bf16_t*)(ws + OFF_PRKV);
        EPI_LOOP( float g[8], o[8]; unpack8(*(const u32x4*)(gb + (size_t)row * 2048 + col), g);
            _Pragma("unroll") for (int j = 0; j < 8; ++j) o[j] = sigmoidf_(g[j]) * v[j];
            *(u32x4*)(m1b + (size_t)row * 1024 + col) = pack8(o); )
    }
};
struct EpiC2 {
    static constexpr bool PERM = true, AFTER_DRAIN = false, SPLIT_A = false;
    unsigned char* ws; const float* gates;
    __device__ __forceinline__ void operator()(const f32x4 (&acc)[2][2][4][2], const Unit& u, int wr, int wc, int fr, int fq) const {
        const bf16_t* gb = (const bf16_t*)gates + 1024; const bf16_t* m1b = (const bf16_t*)(ws + OFF_PRKV); bf16_t* mg = (bf16_t*)(ws + OFF_GQKV);
        EPI_LOOP( float g[8], m1[8], o[8]; unpack8(*(const u32x4*)(gb + (size_t)row * 2048 + col), g); unpack8(*(const u32x4*)(m1b + (size_t)row * 1024 + col), m1);
            _Pragma("unroll") for (int j = 0; j < 8; ++j) o[j] = m1[j] + sigmoidf_(g[j]) * v[j];
            *(u32x4*)(mg + (size_t)row * 1024 + col) = pack8(o); )
    }
};
struct EpiAB {
    static constexpr bool PERM = true, AFTER_DRAIN = false, SPLIT_A = true;
    unsigned char* ws; const float* gates;
    __device__ __forceinline__ void mid(f32x4 (&acc)[2][2][4][2], const Unit& u, int wr, int wc, int fr, int fq) const {
        asm volatile("" : "+v"(fr), "+v"(fq));
        const bf16_t* gb = (const bf16_t*)gates;
        const int row0 = u.pm * 256 + wr * 64 + fr, col0 = u.pn * 256 + wc * 32 + 8 * fq;
#pragma unroll
        for (int ai = 0; ai < 2; ++ai)
#pragma unroll
            for (int mp = 0; mp < 2; ++mp) {
                u32x4 ra[2][2], rb[2][2];
#pragma unroll
                for (int mm = 0; mm < 2; ++mm)
#pragma unroll
                    for (int bj = 0; bj < 2; ++bj) { const size_t o = (size_t)(row0 + ai * 128 + (mp * 2 + mm) * 16) * 2048 + col0 + bj * 128; ra[mm][bj] = *(const u32x4*)(gb + o); rb[mm][bj] = *(const u32x4*)(gb + o + 1024); }
                PIN();
#pragma unroll
                for (int mm = 0; mm < 2; ++mm)
#pragma unroll
                    for (int bj = 0; bj < 2; ++bj) {
                        float ga[8], gv[8]; unpack8(ra[mm][bj], ga); unpack8(rb[mm][bj], gv);
                        const int m = mp * 2 + mm;
#pragma unroll
                        for (int j = 0; j < 4; ++j) {
                            acc[ai][bj][m][0][j] *= sigmoidf_(ga[j]) * (1.f + __expf(fminf(-gv[j], 80.f)));
                            acc[ai][bj][m][1][j] *= sigmoidf_(ga[4 + j]) * (1.f + __expf(fminf(-gv[4 + j], 80.f)));
                        }
                    }
                PIN();
            }
    }
    __device__ __forceinline__ void operator()(const f32x4 (&acc)[2][2][4][2], const Unit& u, int wr, int wc, int fr, int fq) const {
        asm volatile("" : "+v"(fr), "+v"(fq));
        const bf16_t* gb = (const bf16_t*)gates + 1024; bf16_t* mg = (bf16_t*)(ws + OFF_GQKV);
        const int row0 = u.pm * 256 + wr * 64 + fr, col0 = u.pn * 256 + wc * 32 + 8 * fq;
#pragma unroll
        for (int ai = 0; ai < 2; ++ai)
#pragma unroll
            for (int mp = 0; mp < 2; ++mp) {
                u32x4 rg[2][2];
#pragma unroll
                for (int mm = 0; mm < 2; ++mm)
#pragma unroll
                    for (int bj = 0; bj < 2; ++bj) rg[mm][bj] = *(const u32x4*)(gb + (size_t)(row0 + ai * 128 + (mp * 2 + mm) * 16) * 2048 + col0 + bj * 128);
                PIN();
#pragma unroll
                for (int mm = 0; mm < 2; ++mm)
#pragma unroll
                    for (int bj = 0; bj < 2; ++bj) {
                        const int m = mp * 2 + mm; float g[8], o[8]; unpack8(rg[mm][bj], g);
#pragma unroll
                        for (int j = 0; j < 4; ++j) { o[j] = sigmoidf_(g[j]) * acc[ai][bj][m][0][j]; o[4 + j] = sigmoidf_(g[4 + j]) * acc[ai][bj][m][1][j]; }
                        *(u32x4*)(mg + (size_t)(row0 + ai * 128 + m * 16) * 1024 + col0 + bj * 128) = pack8(o);
                    }
                PIN();
            }
    }
};
struct EpiC3 {
    static constexpr bool PERM = true, AFTER_DRAIN = false, SPLIT_A = false;
    const float* x; float* out; float* rss;
    __device__ __forceinline__ void operator()(const f32x4 (&acc)[2][2][4][2], const Unit& u, int wr, int wc, int fr, int fq) const {
        asm volatile("" : "+v"(fr), "+v"(fq));
        const int row0 = u.pm * 256 + wr * 64 + fr, col0 = u.pn * 256 + wc * 32 + 8 * fq;
#pragma unroll
        for (int ai = 0; ai < 2; ++ai)
#pragma unroll
            for (int mp = 0; mp < 2; ++mp) {
                f32x4 xa[2][2], xb[2][2];
#pragma unroll
                for (int mm = 0; mm < 2; ++mm)
#pragma unroll
                    for (int bj = 0; bj < 2; ++bj) { const size_t o = (size_t)(row0 + ai * 128 + (mp * 2 + mm) * 16) * 1024 + col0 + bj * 128; xa[mm][bj] = *(const f32x4*)(x + o); xb[mm][bj] = *(const f32x4*)(x + o + 4); }
                PIN();
#pragma unroll
                for (int mm = 0; mm < 2; ++mm) {
                    const int m = mp * 2 + mm, row = row0 + ai * 128 + m * 16; float ss = 0.f;
#pragma unroll
                    for (int bj = 0; bj < 2; ++bj) {
                        const size_t o = (size_t)row * 1024 + col0 + bj * 128;
                        const f32x4 a = xa[mm][bj] + acc[ai][bj][m][0], b = xb[mm][bj] + acc[ai][bj][m][1];
                        *(f32x4*)(out + o) = a; *(f32x4*)(out + o + 4) = b;
                        ss += a[0] * a[0] + a[1] * a[1] + a[2] * a[2] + a[3] * a[3] + b[0] * b[0] + b[1] * b[1] + b[2] * b[2] + b[3] * b[3];
                    }
                    ss += __shfl_xor(ss, 16); ss += __shfl_xor(ss, 32);
                    if (fq == 0) atomicAdd(rss + row, ss);
                }
                PIN();
            }
    }
};

__device__ __forceinline__ int in_src_col(int n) {
    if (n < 1664) return n;
    if (n < 1672) return 4224 + (n - 1664);
    if (n < 1792) return -1;
    if (n < 2304) return 1664 + (n - 1792);
    if (n < 3840) return 2176 + (n - 2304);
    if (n < 4352) return 3712 + (n - 3840);
    return 4232 + (n - 4352);
}
template <int WHICH> __device__ __forceinline__ float wsrc(const Params& p, int n, int k) {
    if (WHICH == 0) { const int s = in_src_col(n); return s >= 0 ? p.w_in[(size_t)k * INC + s] : 0.f; }
    if (WHICH == 1) return k < 512 ? p.w_branch_a[(size_t)k * 1024 + n] : p.w_branch_b[(size_t)(k - 512) * 1024 + n];
    if (WHICH == 3) return p.w_out[(size_t)k * 1024 + n];
    if (n < 512) return k < 64 ? p.rw_w2[k * 512 + n] : 0.f;
    return (k >= 64 && k < 128) ? p.rw_a2[(k - 64) * 512 + (n - 512)] : 0.f;
}
template <int WHICH> __device__ __forceinline__ void transpose_tile(const Params& p, float* lds, bf16_t* Bt, int K, int n0, int k0) {
    const int tid = otid(), c = tid & 63, r = tid >> 6;
    float v[8];
#pragma unroll
    for (int q = 0; q < 8; ++q) v[q] = wsrc<WHICH>(p, n0 + c, k0 + r + 8 * q);
    __syncthreads();
#pragma unroll
    for (int q = 0; q < 8; ++q) lds[(r + 8 * q) * 65 + c] = v[q];
    __syncthreads();
#pragma unroll
    for (int q = 0; q < 8; ++q) Bt[(size_t)(n0 + r + 8 * q) * K + k0 + c] = f2bf(lds[c * 65 + r + 8 * q]);
}
__device__ void later_weight_tiles(const Params& p, float* lds, int rank, int n) {
    for (int t = 1600 + rank; t < 2176; t += n) {
        if (t < 1856) { const int u = t - 1600; transpose_tile<1>(p, lds, (bf16_t*)(p.ws + OFF_BTA), 1024, (u >> 4) * 64, (u & 15) * 64); }
        else if (t < 2112) { const int u = t - 1856; transpose_tile<3>(p, lds, (bf16_t*)(p.ws + OFF_BTO), 1024, (u >> 4) * 64, (u & 15) * 64); }
        else { const int u = t - 2112; transpose_tile<4>(p, lds, (bf16_t*)(p.ws + OFF_BTS), 256, (u >> 2) * 64, (u & 3) * 64); }
    }
}
__device__ void phase0(const Params& p, float* lds) {
    const int tid = otid(), lane = tid & 63, gw = blockIdx.x * 8 + (tid >> 6), nw = gridDim.x * 8;
    bf16_t* H = (bf16_t*)(p.ws + OFF_H);
    f32x4 gq[4];
#pragma unroll
    for (int i = 0; i < 4; ++i) gq[i] = *(const f32x4*)(p.norm_in_w + lane * 16 + i * 4);
    for (int r0 = gw; r0 < MTOK; r0 += 4 * nw) {
        f32x4 a[4][4];
#pragma unroll
        for (int q = 0; q < 4; ++q) { const int row = min(r0 + q * nw, MTOK - 1);
#pragma unroll
            for (int i = 0; i < 4; ++i) a[q][i] = *(const f32x4*)(p.x + (size_t)row * 1024 + lane * 16 + i * 4); }
        PIN();
#pragma unroll
        for (int q = 0; q < 4; ++q) {
            const int row = r0 + q * nw; if (row >= MTOK) break;
            float ss = 0.f;
#pragma unroll
            for (int i = 0; i < 4; ++i) ss += a[q][i][0] * a[q][i][0] + a[q][i][1] * a[q][i][1] + a[q][i][2] * a[q][i][2] + a[q][i][3] * a[q][i][3];
            ss = wave_sum(ss);
            const float rs = rsqrtf(ss * (1.f / 1024.f) + 1e-6f);
            float o[16];
#pragma unroll
            for (int i = 0; i < 4; ++i)
#pragma unroll
                for (int j = 0; j < 4; ++j) o[i * 4 + j] = a[q][i][j] * rs * gq[i][j];
            u32x4 w0, w1; w0.x = pk2(o[0], o[1]); w0.y = pk2(o[2], o[3]); w0.z = pk2(o[4], o[5]); w0.w = pk2(o[6], o[7]);
            w1.x = pk2(o[8], o[9]); w1.y = pk2(o[10], o[11]); w1.z = pk2(o[12], o[13]); w1.w = pk2(o[14], o[15]);
            *(u32x4*)(H + (size_t)row * 1024 + lane * 16) = w0; *(u32x4*)(H + (size_t)row * 1024 + lane * 16 + 8) = w1;
        }
    }
    for (int t = blockIdx.x; t < 1600; t += gridDim.x) transpose_tile<0>(p, lds, (bf16_t*)(p.ws + OFF_BTIN), 1024, (t >> 4) * 64, (t & 15) * 64);
    float* rss = (float*)(p.ws + OFF_RSS);
    for (int i = blockIdx.x * 512 + tid; i < MTOK; i += gridDim.x * 512) rss[i] = 0.f;
}

__device__ void phase2(const Params& p) {
    const int tid = otid(), lane = tid & 63;
    const float* PX = (const float*)(p.ws + OFF_PX);
    bf16_t* AP = (bf16_t*)(p.ws + OFF_AP);
    for (int task = blockIdx.x * 512 + tid; task < (MTOK / 16) * 128; task += gridDim.x * 512) {
        const int j = task & 127, m0 = (task >> 7) * 16;
        float v[17];
        v[0] = (m0 & (TSEQ - 1)) ? PX[(size_t)(m0 - 1) * 136 + j] : 0.f;
#pragma unroll
        for (int t = 0; t < 16; ++t) v[t + 1] = PX[(size_t)(m0 + t) * 136 + j];
        PIN();
        const float mu = p.rw_mu[1536 + j];
#pragma unroll
        for (int t = 0; t < 16; ++t) {
            float xs = v[t + 1] + (v[t] - v[t + 1]) * mu;
            if (j < 64) xs = tanhf(xs);
            AP[(size_t)(m0 + t) * 256 + j] = f2bf(xs); AP[(size_t)(m0 + t) * 256 + 128 + j] = 0;
        }
    }
    const bf16_t* QKV = (const bf16_t*)(p.ws + OFF_QKV);
    bf16_t* GQ = (bf16_t*)(p.ws + OFF_GQKV);
    const int gw = blockIdx.x * 8 + (tid >> 6), nw = gridDim.x * 8;
    for (int task = gw; task < (MTOK / 16) * 3; task += nw) {
        const int grp = task % 3, m0 = (task / 3) * 16;
        const int ch = grp * 512 + lane * 8;
        float cw[4][8];
#pragma unroll
        for (int i = 0; i < 4; ++i) { const f32x4 a = *(const f32x4*)(p.gd_conv_w + i * 1536 + ch), b = *(const f32x4*)(p.gd_conv_w + i * 1536 + ch + 4);
#pragma unroll
            for (int j = 0; j < 4; ++j) { cw[i][j] = a[j]; cw[i][4 + j] = b[j]; } }
        float x1[8], x2[8], x3[8];
        if (m0 & (TSEQ - 1)) {
            unpack8(*(const u32x4*)(QKV + (size_t)(m0 - 1) * 1536 + ch), x1); unpack8(*(const u32x4*)(QKV + (size_t)(m0 - 2) * 1536 + ch), x2); unpack8(*(const u32x4*)(QKV + (size_t)(m0 - 3) * 1536 + ch), x3);
        } else {
#pragma unroll
            for (int j = 0; j < 8; ++j) { x1[j] = 0.f; x2[j] = 0.f; x3[j] = 0.f; }
        }
        u32x4 raw[16];
#pragma unroll
        for (int t = 0; t < 16; ++t) raw[t] = *(const u32x4*)(QKV + (size_t)(m0 + t) * 1536 + ch);
        PIN();
#pragma unroll
        for (int t = 0; t < 16; ++t) {
            const int m = m0 + t; float x0[8], y[8]; unpack8(raw[t], x0);
            float ss = 0.f;
#pragma unroll
            for (int j = 0; j < 8; ++j) { const float c = cw[0][j] * x3[j] + cw[1][j] * x2[j] + cw[2][j] * x1[j] + cw[3][j] * x0[j]; y[j] = c * sigmoidf_(c); ss += y[j] * y[j]; x3[j] = x2[j]; x2[j] = x1[j]; x1[j] = x0[j]; }
            if (grp < 2) {
                ss = row_sum16(ss);
                const float sc = rsqrtf(ss + 1e-12f);
#pragma unroll
                for (int j = 0; j < 8; ++j) y[j] *= sc;
            }
            *(u32x4*)(GQ + (size_t)m * 1536 + ch) = pack8(y);
        }
    }
}

typedef float f32x2 __attribute__((ext_vector_type(2)));
#define LO2(v4) __builtin_shufflevector(v4, v4, 0, 1)
#define HI2(v4) __builtin_shufflevector(v4, v4, 2, 3)
#define FMA2(a, b, c) __builtin_elementwise_fma(a, b, c)
__device__ __forceinline__ float dot8(const f32x2 (&S2)[4], const f32x4 a, const f32x4 b) {
    f32x2 t = S2[0] * LO2(a); t = FMA2(S2[1], HI2(a), t); t = FMA2(S2[2], LO2(b), t); t = FMA2(S2[3], HI2(b), t); return t.x + t.y;
}
__device__ __forceinline__ float sum8(float v) {
    v += __int_as_float(__builtin_amdgcn_update_dpp(0, __float_as_int(v), 0xB1, 0xF, 0xF, true));
    v += __int_as_float(__builtin_amdgcn_update_dpp(0, __float_as_int(v), 0x4E, 0xF, 0xF, true));
    v += __int_as_float(__builtin_amdgcn_update_dpp(0, __float_as_int(v), 0x141, 0xF, 0xF, true));
    return v;
}
#define DPPADD(v, ctrl) v += __int_as_float(__builtin_amdgcn_update_dpp(0, __float_as_int(v), ctrl, 0xF, 0xF, true))
__device__ __forceinline__ void sum8x4(float& a, float& b, float& c, float& d) {
    DPPADD(a, 0xB1); DPPADD(b, 0xB1); DPPADD(c, 0xB1); DPPADD(d, 0xB1);
    DPPADD(a, 0x4E); DPPADD(b, 0x4E); DPPADD(c, 0x4E); DPPADD(d, 0x4E);
    DPPADD(a, 0x141); DPPADD(b, 0x141); DPPADD(c, 0x141); DPPADD(d, 0x141);
}
#define RWKV_LOAD(T0, W, CH) do { const size_t mw_ = (size_t)b * TSEQ + (T0) + 8 * (W); \
        if ((T0) + 8 * (W) > 0) { pr[0] = bf2f(PRKV[(mw_ - 1) * 1536 + (CH)]); pk[0] = bf2f(PRKV[(mw_ - 1) * 1536 + 512 + (CH)]); pv[0] = bf2f(PRKV[(mw_ - 1) * 1536 + 1024 + (CH)]); } \
        else { pr[0] = 0.f; pk[0] = 0.f; pv[0] = 0.f; } \
        _Pragma("unroll") for (int i = 0; i < 8; ++i) { const size_t m = mw_ + i; pr[i + 1] = bf2f(PRKV[m * 1536 + (CH)]); pk[i + 1] = bf2f(PRKV[m * 1536 + 512 + (CH)]); pv[i + 1] = bf2f(PRKV[m * 1536 + 1024 + (CH)]); \
            aa[i] = bf2f(AA[m * 512 + (CH)]); dd[i] = DEC[m * 512 + (CH)]; } } while (0)
__device__ void rwkv_scan(const Params& p, float* lds, int task) {
    const int b = task >> 3, h = task & 7, tid = otid(), w_ = tid >> 6, lane_ = tid & 63;
    constexpr int LD = 68;
    float *AT = lds, *QT = AT + 64 * LD, *BT = QT + 64 * LD, *KT = BT + 64 * LD, *G8 = KT + 64 * LD, *Vv0 = G8 + 512, *CF = Vv0 + 4096, *RED = CF + 2048, *YACC = RED + 8192, *BON0 = YACC + 4096;
    const bf16_t* PRKV = (const bf16_t*)(p.ws + OFF_PRKV); const bf16_t* AA = (const bf16_t*)(p.ws + OFF_AA); const float* DEC = (const float*)(p.ws + OFF_H);
    const bf16_t* ZRW = (const bf16_t*)(p.ws + OFF_ZRW); bf16_t* YA = (bf16_t*)(p.ws + OFF_QKV);
    f32x2 S2[4];
#pragma unroll
    for (int j = 0; j < 4; ++j) S2[j] = (f32x2){0.f, 0.f};
#pragma unroll
    for (int mq_ = 0; mq_ < 4; ++mq_) CF[(w_ * 4 + mq_) * 64 + lane_] = 0.f;
    float pr[9], pk[9], pv[9], aa[8], dd[8];
    RWKV_LOAD(0, w_, h * 64 + lane_);
    for (int blk = 0; blk < TSEQ / 64; ++blk) {
        const int t0 = blk * 64;
        float* const Vv = (blk & 1) ? RED : Vv0; float* const BON = (blk & 1) ? RED + 4096 : BON0;
        int w = w_, lane = lane_; asm volatile("" : "+v"(w), "+v"(lane));
        const int ch = h * 64 + lane;
        {
            const float mu_r = p.rw_mu[ch], mu_k = p.rw_mu[512 + ch], mu_v = p.rw_mu[1024 + ch], kkc = p.rw_k_k[ch], kac = p.rw_k_a[ch], rkc = p.rw_r_k[ch], w0c = p.rw_w0[ch], a0c = p.rw_a0[ch];
            float G = 1.f;
#pragma unroll
            for (int i = 0; i < 8; ++i) {
                const int s = 8 * w + i;
                const float r = pr[i + 1] + (pr[i] - pr[i + 1]) * mu_r, k = pk[i + 1] + (pk[i] - pk[i + 1]) * mu_k, v = pv[i + 1] + (pv[i] - pv[i + 1]) * mu_v;
                const float a = sigmoidf_(a0c + aa[i]), dec = __expf(-0.6065306597f * sigmoidf_(w0c + dd[i]));
                const float kkr = k * kkc; const float ssq = wave_sum(kkr * kkr); const float kk = kkr * rsqrtf(ssq + 1e-12f);
                const float kp = k * (1.f + (a - 1.f) * kac);
                const float bon = wave_sum(r * kp * rkc);
                const float Gp = G; G *= dec; const float iG = __builtin_amdgcn_rcpf(G);
                AT[s * LD + lane] = -kk * Gp; QT[s * LD + lane] = r * G; BT[s * LD + lane] = kk * a * iG; KT[s * LD + lane] = kp * iG; Vv[s * 64 + lane] = v;
                if (lane == 0) BON[s] = bon;
            }
            G8[w * 64 + lane] = G;
            const bool isM = lane < 36; const int idx = isM ? lane : lane - 36;
            const int tt_ = (idx >= 1) + (idx >= 3) + (idx >= 6) + (idx >= 10) + (idx >= 15) + (idx >= 21) + (idx >= 28);
            const int tq = isM ? tt_ : tt_ + 1, jq = idx - tt_ * (tt_ + 1) / 2;
            const float *rt = (isM ? QT : AT) + (8 * w + tq) * LD, *bj = BT + (8 * w + jq) * LD, *kj = KT + (8 * w + jq) * LD;
            float db = 0.f, dk = 0.f;
#pragma unroll 1
            for (int c = 0; c < 64; c += 16) {
                f32x4 a4[4], b4[4], k4[4];
#pragma unroll
                for (int i = 0; i < 4; ++i) { a4[i] = LD4(rt + c + 4 * i); b4[i] = LD4(bj + c + 4 * i); k4[i] = LD4(kj + c + 4 * i); }
                PIN();
#pragma unroll
                for (int i = 0; i < 4; ++i)
#pragma unroll
                    for (int e = 0; e < 4; ++e) { db += a4[i][e] * b4[i][e]; dk += a4[i][e] * k4[i][e]; }
            }
            CF[(w * 4 + (isM ? 2 : 0)) * 64 + tq * 8 + jq] = db; CF[(w * 4 + (isM ? 3 : 1)) * 64 + tq * 8 + jq] = dk;
        }
        __syncthreads();
        if (blk + 1 < TSEQ / 64) RWKV_LOAD(t0 + 64, w, ch);
        const int r = lane >> 3, ko = lane & 7;
        for (int mb = 0; mb < 8; ++mb) {
            float u[8], vv[8], pq[8];
            int cfo = mb * 256; asm volatile("" : "+v"(cfo));
            const float* cf = CF + cfo;
            f32x4 DA[2][8];
#define RW_LD_DOTS(buf, tp) do { const float *ap_ = AT + (mb * 8 + (tp) * 2) * LD + ko * 8, *qp_ = QT + (mb * 8 + (tp) * 2) * LD + ko * 8; \
                DA[buf][0] = LD4(ap_); DA[buf][1] = LD4(ap_ + 4); DA[buf][2] = LD4(ap_ + LD); DA[buf][3] = LD4(ap_ + LD + 4); DA[buf][4] = LD4(qp_); DA[buf][5] = LD4(qp_ + 4); DA[buf][6] = LD4(qp_ + LD); DA[buf][7] = LD4(qp_ + LD + 4); } while (0)
            RW_LD_DOTS(0, 0);
            f32x4 La[4], Ka[4];
#pragma unroll
            for (int tp = 0; tp < 4; ++tp) {
                if (tp < 3) RW_LD_DOTS((tp + 1) & 1, tp + 1);
                else {
#pragma unroll
                    for (int t = 0; t < 8; ++t) vv[t] = Vv[(mb * 8 + t) * 64 + w * 8 + r];
#pragma unroll
                    for (int t = 1; t < 4; ++t) { La[t] = LD4(cf + t * 8); Ka[t] = LD4(cf + 64 + t * 8); }
                }
                PIN();
                u[tp * 2] = dot8(S2, DA[tp & 1][0], DA[tp & 1][1]); u[tp * 2 + 1] = dot8(S2, DA[tp & 1][2], DA[tp & 1][3]);
                pq[tp * 2] = dot8(S2, DA[tp & 1][4], DA[tp & 1][5]); pq[tp * 2 + 1] = dot8(S2, DA[tp & 1][6], DA[tp & 1][7]);
                sum8x4(u[tp * 2], u[tp * 2 + 1], pq[tp * 2], pq[tp * 2 + 1]);
            }
#undef RW_LD_DOTS
            f32x4 L0[4], L1[4], K0[4], K1[4];
#pragma unroll
            for (int t = 0; t < 4; ++t) { L0[t] = LD4(cf + (4 + t) * 8); L1[t] = LD4(cf + (4 + t) * 8 + 4); K0[t] = LD4(cf + 64 + (4 + t) * 8); K1[t] = LD4(cf + 64 + (4 + t) * 8 + 4); }
            PIN();
#pragma unroll
            for (int t = 1; t < 4; ++t) { float x = u[t];
#pragma unroll
                for (int j = 0; j < 3; ++j) if (j < t) x += La[t][j] * u[j] + Ka[t][j] * vv[j];
                u[t] = x; }
            const f32x4 m0 = LD4(cf + 128 + ko * 8), m1 = LD4(cf + 128 + ko * 8 + 4), n0 = LD4(cf + 192 + ko * 8), n1 = LD4(cf + 192 + ko * 8 + 4);
            f32x4 UB[2][8];
#define RW_LD_UPD(buf, jp) do { const float *bp_ = BT + (mb * 8 + (jp) * 2) * LD + ko * 8, *kp_ = KT + (mb * 8 + (jp) * 2) * LD + ko * 8; \
                UB[buf][0] = LD4(bp_); UB[buf][1] = LD4(bp_ + 4); UB[buf][2] = LD4(bp_ + LD); UB[buf][3] = LD4(bp_ + LD + 4); UB[buf][4] = LD4(kp_); UB[buf][5] = LD4(kp_ + 4); UB[buf][6] = LD4(kp_ + LD); UB[buf][7] = LD4(kp_ + LD + 4); } while (0)
            RW_LD_UPD(0, 0);
            PIN();
#pragma unroll
            for (int t = 0; t < 4; ++t) { float x = u[4 + t];
#pragma unroll
                for (int j = 0; j < 4; ++j) { x += L0[t][j] * u[j] + K0[t][j] * vv[j]; if (j < t) x += L1[t][j] * u[4 + j] + K1[t][j] * vv[4 + j]; }
                u[4 + t] = x; }
            {
                float yc = pq[0];
#pragma unroll
                for (int t = 1; t < 8; ++t) yc = (ko == t) ? pq[t] : yc;
#pragma unroll
                for (int j = 0; j < 4; ++j) yc += m0[j] * u[j] + n0[j] * vv[j] + m1[j] * u[4 + j] + n1[j] * vv[4 + j];
                YACC[(mb * 8 + ko) * 64 + w * 8 + r] = yc;
            }
            f32x2 acc[4];
#pragma unroll
            for (int k = 0; k < 4; ++k) acc[k] = S2[k];
            f32x4 g0, g1;
#pragma unroll
            for (int jp = 0; jp < 4; ++jp) {
                if (jp < 3) RW_LD_UPD((jp + 1) & 1, jp + 1);
                else { g0 = LD4(G8 + mb * 64 + ko * 8); g1 = LD4(G8 + mb * 64 + ko * 8 + 4); }
                PIN();
                const f32x4 B0 = UB[jp & 1][0], B1 = UB[jp & 1][1], B2 = UB[jp & 1][2], B3 = UB[jp & 1][3], C0 = UB[jp & 1][4], C1 = UB[jp & 1][5], C2 = UB[jp & 1][6], C3 = UB[jp & 1][7];
                const f32x2 ua = (f32x2){u[jp * 2], u[jp * 2]}, ub = (f32x2){u[jp * 2 + 1], u[jp * 2 + 1]}, va = (f32x2){vv[jp * 2], vv[jp * 2]}, vb = (f32x2){vv[jp * 2 + 1], vv[jp * 2 + 1]};
                acc[0] = FMA2(LO2(B0), ua, acc[0]); acc[1] = FMA2(HI2(B0), ua, acc[1]); acc[2] = FMA2(LO2(B1), ua, acc[2]); acc[3] = FMA2(HI2(B1), ua, acc[3]);
                acc[0] = FMA2(LO2(C0), va, acc[0]); acc[1] = FMA2(HI2(C0), va, acc[1]); acc[2] = FMA2(LO2(C1), va, acc[2]); acc[3] = FMA2(HI2(C1), va, acc[3]);
                acc[0] = FMA2(LO2(B2), ub, acc[0]); acc[1] = FMA2(HI2(B2), ub, acc[1]); acc[2] = FMA2(LO2(B3), ub, acc[2]); acc[3] = FMA2(HI2(B3), ub, acc[3]);
                acc[0] = FMA2(LO2(C2), vb, acc[0]); acc[1] = FMA2(HI2(C2), vb, acc[1]); acc[2] = FMA2(LO2(C3), vb, acc[2]); acc[3] = FMA2(HI2(C3), vb, acc[3]);
            }
#undef RW_LD_UPD
            S2[0] = LO2(g0) * acc[0]; S2[1] = HI2(g0) * acc[1]; S2[2] = LO2(g1) * acc[2]; S2[3] = HI2(g1) * acc[3];
        }
        __syncthreads();
        asm volatile("" : "+v"(w), "+v"(lane));
        const int ch2 = h * 64 + lane;
        const float gnw = p.rw_gn_w[ch2], gnb = p.rw_gn_b[ch2];
        float zz[8];
#pragma unroll
        for (int i = 0; i < 8; ++i) zz[i] = bf2f(ZRW[((size_t)b * TSEQ + t0 + w + 8 * i) * 512 + ch2]);
#pragma unroll
        for (int i = 0; i < 8; ++i) {
            const int s = w + 8 * i; const size_t m = (size_t)b * TSEQ + t0 + s;
            const float y = YACC[s * 64 + lane];
            const float mean = wave_sum(y) * (1.f / 64.f); const float d = y - mean; const float var = wave_sum(d * d) * (1.f / 64.f);
            const float o = d * rsqrtf(var + 64e-5f) * gnw + gnb + BON[s] * Vv[s * 64 + lane];
            const float z = zz[i];
            YA[m * 512 + ch2] = f2bf(o * z * sigmoidf_(z));
        }
    }
}
#define GDN_LOAD(MB0, TID) do { \
        _Pragma("unroll") for (int i = 0; i < 2; ++i) { const int cidx = (TID) + i * 512, s = cidx >> 4, j = (cidx & 15) * 8; const size_t o = ((MB0) + s) * 1536 + h * 128 + j; \
            rq[i] = *(const u32x4*)(GQ + o); rk[i] = *(const u32x4*)(GQ + o + 512); } \
        { const int s = (TID) >> 3, c = ((TID) & 7) * 8; rv = *(const u32x4*)(GQ + ((MB0) + s) * 1536 + 1024 + h * 128 + half * 64 + c); } \
        { const float* px = PX + ((MB0) + ((TID) & 63)) * 136; pxb = px[128 + h]; pxa = px[132 + h]; } } while (0)
__device__ void gdn_scan(const Params& p, float* lds, int task) {
    const int half = task & 1, h = (task >> 1) & 3, b = task >> 3, tid_ = otid();
    constexpr int LD = 132;
    float *Q = lds, *K = Q + 64 * LD, *V = K + 64 * LD, *CF = V + 4096, *RED = CF + 1024, *OACC = RED + 8192, *LG = OACC + 4096, *BE = LG + 64, *EG = BE + 64, *ER = EG + 64;
    const bf16_t* GQ = (const bf16_t*)(p.ws + OFF_GQKV); const float* PX = (const float*)(p.ws + OFF_PX);
    float* OB = (float*)(p.ws + OFF_QKV + 33554432ull);
    const float nA = -__expf(p.gd_A_log[h]), dtb = p.gd_dt_bias[h];
    f32x2 S2[8];
#pragma unroll
    for (int j = 0; j < 8; ++j) S2[j] = (f32x2){0.f, 0.f};
    { const int w0_ = tid_ >> 6, l0_ = tid_ & 63; CF[(w0_ * 2) * 64 + l0_] = 0.f; CF[(w0_ * 2 + 1) * 64 + l0_] = 0.f; }
    u32x4 rq[2], rk[2], rv; float pxb, pxa;
    GDN_LOAD((size_t)b * TSEQ, tid_);
    for (int blk = 0; blk < TSEQ / 64; ++blk) {
        const size_t mb0 = (size_t)b * TSEQ + blk * 64;
        int tid = tid_; asm volatile("" : "+v"(tid));
        const int w = tid >> 6, lane = tid & 63;
        {
#pragma unroll
            for (int i = 0; i < 2; ++i) { const int cidx = tid + i * 512, s = cidx >> 4, j = (cidx & 15) * 8; float f[8];
                unpack8(rq[i], f);
                *(f32x4*)(Q + s * LD + j) = (f32x4){f[0], f[1], f[2], f[3]} * 0.08838834764831845f; *(f32x4*)(Q + s * LD + j + 4) = (f32x4){f[4], f[5], f[6], f[7]} * 0.08838834764831845f;
                unpack8(rk[i], f);
                *(f32x4*)(K + s * LD + j) = (f32x4){f[0], f[1], f[2], f[3]}; *(f32x4*)(K + s * LD + j + 4) = (f32x4){f[4], f[5], f[6], f[7]}; }
            { const int s = tid >> 3, c = (tid & 7) * 8; float f[8]; unpack8(rv, f);
                *(f32x4*)(V + s * 64 + c) = (f32x4){f[0], f[1], f[2], f[3]}; *(f32x4*)(V + s * 64 + c + 4) = (f32x4){f[4], f[5], f[6], f[7]}; }
        }
        if (tid < 64) {
            BE[tid] = sigmoidf_(pxb);
            float c = nA * softplusf_(pxa + dtb);
#pragma unroll
            for (int off = 1; off < 4; off <<= 1) { const float n = __shfl_up(c, off); if ((tid & 3) >= off) c += n; }
            LG[tid] = c; EG[tid] = __expf(c);
            const float cend = __shfl(c, tid | 3); ER[tid] = __expf(cend - c);
        }
        __syncthreads();
        {
            const int hf = lane & 1, pidx = lane >> 1, gq = pidx >> 4, q = pidx & 15;
            const bool isM = q < 10; const int rr = isM ? q : q - 10;
            const int tt_ = isM ? ((rr >= 1) + (rr >= 3) + (rr >= 6)) : ((rr >= 1) + (rr >= 3));
            const int t4 = isM ? tt_ : tt_ + 1, j4 = rr - tt_ * (tt_ + 1) / 2;
            const int st = 8 * w + 4 * gq + t4, sj = 8 * w + 4 * gq + j4;
            const float *ra = (isM ? Q : K) + st * LD + hf * 64, *rb = K + sj * LD + hf * 64;
            float dsum = 0.f;
#pragma unroll
            for (int c = 0; c < 64; c += 32) {
                f32x4 a4[8], b4[8];
#pragma unroll
                for (int i = 0; i < 8; ++i) { a4[i] = LD4(ra + c + 4 * i); b4[i] = LD4(rb + c + 4 * i); }
                PIN();
#pragma unroll
                for (int i = 0; i < 8; ++i)
#pragma unroll
                    for (int e = 0; e < 4; ++e) dsum += a4[i][e] * b4[i][e];
            }
            DPPADD(dsum, 0xB1);
            const float ratio = __expf(fminf(LG[st] - LG[sj], 0.f));
            const float val = isM ? ratio * dsum : BE[st] * ratio * dsum;
            if (hf == 0) CF[(w * 2 + (isM ? 1 : 0)) * 64 + (4 * gq + t4) * 8 + 4 * gq + j4] = val;
        }
        __syncthreads();
        if (blk + 1 < TSEQ / 64) GDN_LOAD(mb0 + 64, tid);
        const int r = lane >> 3, ko = lane & 7;
        for (int g = 0; g < 16; ++g) {
            const int s0 = g * 4, hb = (g & 1) * 4;
            const float *kp = K + s0 * LD + ko * 16, *qp = Q + s0 * LD + ko * 16;
            f32x4 KK[4][4];
            float d[4], c[4], pe[4];
#pragma unroll
            for (int tp = 0; tp < 2; ++tp) {
                f32x4 QQ[2][4];
#pragma unroll
                for (int t = 0; t < 2; ++t)
#pragma unroll
                    for (int j = 0; j < 4; ++j) { KK[tp * 2 + t][j] = LD4(kp + (tp * 2 + t) * LD + j * 4); QQ[t][j] = LD4(qp + (tp * 2 + t) * LD + j * 4); }
                PIN();
                f32x2 x0 = S2[0] * LO2(KK[tp * 2][0]), y0 = S2[0] * LO2(QQ[0][0]), x1 = S2[0] * LO2(KK[tp * 2 + 1][0]), y1 = S2[0] * LO2(QQ[1][0]);
                x0 = FMA2(S2[1], HI2(KK[tp * 2][0]), x0); y0 = FMA2(S2[1], HI2(QQ[0][0]), y0); x1 = FMA2(S2[1], HI2(KK[tp * 2 + 1][0]), x1); y1 = FMA2(S2[1], HI2(QQ[1][0]), y1);
#pragma unroll
                for (int j = 1; j < 4; ++j) {
                    x0 = FMA2(S2[2 * j], LO2(KK[tp * 2][j]), x0); y0 = FMA2(S2[2 * j], LO2(QQ[0][j]), y0); x1 = FMA2(S2[2 * j], LO2(KK[tp * 2 + 1][j]), x1); y1 = FMA2(S2[2 * j], LO2(QQ[1][j]), y1);
                    x0 = FMA2(S2[2 * j + 1], HI2(KK[tp * 2][j]), x0); y0 = FMA2(S2[2 * j + 1], HI2(QQ[0][j]), y0); x1 = FMA2(S2[2 * j + 1], HI2(KK[tp * 2 + 1][j]), x1); y1 = FMA2(S2[2 * j + 1], HI2(QQ[1][j]), y1);
                }
                d[tp * 2] = x0.x + x0.y; d[tp * 2 + 1] = x1.x + x1.y; pe[tp * 2] = y0.x + y0.y; pe[tp * 2 + 1] = y1.x + y1.y;
                sum8x4(d[tp * 2], d[tp * 2 + 1], pe[tp * 2], pe[tp * 2 + 1]);
            }
            float eg[4], er[4], be[4];
#pragma unroll
            for (int t = 0; t < 4; ++t) { c[t] = V[(s0 + t) * 64 + w * 8 + r]; eg[t] = EG[s0 + t]; er[t] = ER[s0 + t]; be[t] = BE[s0 + t]; }
            int cfo = (g >> 1) * 128; asm volatile("" : "+v"(cfo));
            const float* cf = CF + cfo;
            {
                f32x4 L[4];
#pragma unroll
                for (int t = 1; t < 4; ++t) L[t] = LD4(cf + (hb + t) * 8 + hb);
                const f32x4 mq = LD4(cf + 64 + (hb + (ko & 3)) * 8 + hb);
                PIN();
#pragma unroll
                for (int t = 0; t < 4; ++t) {
                    float x = be[t] * (c[t] - eg[t] * d[t]);
#pragma unroll
                    for (int j = 0; j < 3; ++j) if (j < t) x -= L[t < 1 ? 1 : t][j] * c[j];
                    c[t] = x;
                }
                float oc = eg[0] * pe[0];
#pragma unroll
                for (int t = 1; t < 4; ++t) oc = ((ko & 3) == t) ? eg[t] * pe[t] : oc;
#pragma unroll
                for (int j = 0; j < 4; ++j) oc += mq[j] * c[j];
                if (ko < 4) OACC[(s0 + ko) * 64 + w * 8 + r] = oc;
            }
            const f32x2 g4 = (f32x2){eg[3], eg[3]};
#pragma unroll
            for (int k = 0; k < 8; ++k) S2[k] *= g4;
#pragma unroll
            for (int t = 0; t < 4; ++t) {
                const float cs = er[t] * c[t]; const f32x2 c2 = (f32x2){cs, cs};
#pragma unroll
                for (int q = 0; q < 4; ++q) { S2[2 * q] = FMA2(LO2(KK[t][q]), c2, S2[2 * q]); S2[2 * q + 1] = FMA2(HI2(KK[t][q]), c2, S2[2 * q + 1]); }
            }
        }
        __syncthreads();
        for (int idx = tid; idx < 4096; idx += 512) { const int s = idx >> 6, c = idx & 63; OB[(mb0 + s) * 512 + h * 128 + half * 64 + c] = OACC[idx]; }
    }
}
__device__ void phase35(const Params& p) {
    const int tid = otid(), lane = tid & 63, gw = blockIdx.x * 8 + (tid >> 6), nw = gridDim.x * 8;
    const float* OB = (const float*)(p.ws + OFF_QKV + 33554432ull); const bf16_t* ZGD = (const bf16_t*)(p.ws + OFF_ZGD); bf16_t* YB = (bf16_t*)(p.ws + OFF_AA);
    float onw[8];
#pragma unroll
    for (int j = 0; j < 8; ++j) onw[j] = p.gd_o_norm_w[(lane * 8 + j) & 127];
    for (int m0 = gw; m0 < MTOK; m0 += 4 * nw) {
        f32x4 a[4], bq[4]; u32x4 zr[4];
#pragma unroll
        for (int q = 0; q < 4; ++q) { const int m = min(m0 + q * nw, MTOK - 1); a[q] = *(const f32x4*)(OB + (size_t)m * 512 + lane * 8); bq[q] = *(const f32x4*)(OB + (size_t)m * 512 + lane * 8 + 4); zr[q] = *(const u32x4*)(ZGD + (size_t)m * 512 + lane * 8); }
        PIN();
#pragma unroll
        for (int q = 0; q < 4; ++q) {
            const int m = m0 + q * nw; if (m >= MTOK) break;
            float o[8] = {a[q][0], a[q][1], a[q][2], a[q][3], bq[q][0], bq[q][1], bq[q][2], bq[q][3]}, z[8];
            unpack8(zr[q], z);
            float ss = 0.f;
#pragma unroll
            for (int j = 0; j < 8; ++j) ss += o[j] * o[j];
            ss = row_sum16(ss);
            const float rs = rsqrtf(ss * (1.f / 128.f) + 1e-6f);
#pragma unroll
            for (int j = 0; j < 8; ++j) o[j] = o[j] * rs * onw[j] * z[j] * sigmoidf_(z[j]);
            *(u32x4*)(YB + (size_t)m * 512 + lane * 8) = pack8(o);
        }
    }
}
__device__ void phase6(const Params& p) {
    const float* rss = (const float*)(p.ws + OFF_RSS);
    const size_t stride = (size_t)gridDim.x * 512, total = (size_t)MTOK * 256;
    for (size_t i0 = (size_t)blockIdx.x * 512 + otid(); i0 < total; i0 += 4 * stride) {
        f32x4 v[4]; float sq[4];
#pragma unroll
        for (int q = 0; q < 4; ++q) { const size_t i = i0 + q * stride < total ? i0 + q * stride : i0; v[q] = *(const f32x4*)(p.out + i * 4); sq[q] = rss[i >> 8]; }
        PIN();
#pragma unroll
        for (int q = 0; q < 4; ++q) {
            const size_t i = i0 + q * stride; if (i >= total) break;
            const float rs = rsqrtf(sq[q] * (1.f / 1024.f) + 1e-6f); const f32x4 g = *(const f32x4*)(p.norm_out_w + (int)(i & 255) * 4);
            f32x4 o = v[q]; o[0] *= rs * g[0]; o[1] *= rs * g[1]; o[2] *= rs * g[2]; o[3] *= rs * g[3];
            *(f32x4*)(p.out + i * 4) = o;
        }
    }
}

#define XB_TMO      128
#define XB_XCNT(j)  (256  + 64 * (j))
#define XB_XSUB(j)  (1280 + 64 * (j))
#define XB_XGEN(j)  (2304 + 64 * (j))
#define XB_TOP      3328
#define XB_TOPGEN   3392
#define XCD_BAR_WORDS 3456
#define XB_SPIN_CAP (1u << 18)

__device__ __forceinline__ unsigned xb_ld(unsigned* p)              { return __hip_atomic_load(p, __ATOMIC_RELAXED, __HIP_MEMORY_SCOPE_AGENT); }
__device__ __forceinline__ unsigned xb_add(unsigned* p, unsigned v) { return __hip_atomic_fetch_add(p, v, __ATOMIC_RELAXED, __HIP_MEMORY_SCOPE_AGENT); }
__device__ __forceinline__ unsigned xb_xcc_id() { return (unsigned)__builtin_amdgcn_s_getreg((3 << 11) | 20) & 0xFu; }
#define XB_SPIN(cond, bar) do { unsigned _sp = 0; while (cond) { __builtin_amdgcn_s_sleep(1); \
    if ((++_sp & 255u) == 0u) { if (xb_ld(&(bar)[XB_TMO])) break; if (_sp > XB_SPIN_CAP) { atomicAdd(&(bar)[XB_TMO], 1u); break; } } } } while (0)

struct XcdBarrier {
    unsigned* bar; unsigned x;
    volatile LAS unsigned* st;
};

__device__ __forceinline__ XcdBarrier xcd_barrier_post(unsigned* bar, volatile LAS unsigned* st) {
    XcdBarrier b; b.bar = bar; b.x = xb_xcc_id(); b.st = st;
    if (threadIdx.x == 0) (void)xb_add(&bar[XB_XCNT(b.x)], 1u);
    return b;
}
__device__ __forceinline__ void xcd_barrier_complete(unsigned* bar, unsigned x, unsigned& nloc, unsigned& nx) {
    const unsigned G = gridDim.x * gridDim.y * gridDim.z;
    unsigned sum, cnt, mine, sp = 0u;
    for (;;) {
        sum = 0u; cnt = 0u; mine = 0u;
#pragma unroll
        for (unsigned j = 0; j < 16; ++j) { const unsigned c = xb_ld(&bar[XB_XCNT(j)]); sum += c; cnt += (c > 0u) ? 1u : 0u; mine = (j == x) ? c : mine; }
        if (sum == G) break;
        __builtin_amdgcn_s_sleep(1);
        if ((++sp & 255u) == 0u) { if (xb_ld(&bar[XB_TMO])) break; if (sp > XB_SPIN_CAP) { atomicAdd(&bar[XB_TMO], 1u); break; } }
    }
    nloc = mine > 0u ? mine : 1u; nx = cnt > 0u ? cnt : 1u;
}

__device__ __forceinline__ void xcd_barrier(const XcdBarrier& b) {
    asm volatile("s_waitcnt vmcnt(0)" ::: "memory");
    __syncthreads();
    if (threadIdx.x == 0) {
        unsigned* bar = b.bar;
        __builtin_amdgcn_s_waitcnt(0);
        unsigned nloc = b.st[0], nx = b.st[1];
        if (nloc == 0u) { xcd_barrier_complete(bar, b.x, nloc, nx); b.st[0] = nloc; b.st[1] = nx; }
        const unsigned old = xb_add(&bar[XB_XSUB(b.x)], 1u);
        const unsigned gen = old / nloc;
        if (old + 1u == (gen + 1u) * nloc) {
            __builtin_amdgcn_fence(__ATOMIC_RELEASE, "agent");
            asm volatile("s_waitcnt vmcnt(0)" ::: "memory");
            const unsigned og = xb_add(&bar[XB_TOP], 1u);
            const unsigned tg = og / nx;
            if (og + 1u == (tg + 1u) * nx) xb_add(&bar[XB_TOPGEN], 1u);
            else XB_SPIN(xb_ld(&bar[XB_TOPGEN]) == tg, bar);
            __builtin_amdgcn_fence(__ATOMIC_ACQUIRE, "agent");
            xb_add(&bar[XB_XGEN(b.x)], 1u);
            asm volatile("s_waitcnt vmcnt(0)" ::: "memory");
        } else {
            XB_SPIN(xb_ld(&bar[XB_XGEN(b.x)]) == gen, bar);
            __builtin_amdgcn_fence(__ATOMIC_ACQUIRE, "agent");
            asm volatile("s_waitcnt vmcnt(0)" ::: "memory");
        }
    }
    __syncthreads();
}


constexpr int NPHASE = 10;
template <int PH> __device__ __forceinline__ void run_phase(const Params& p, unsigned char* shm) {
    float* ldsf = (float*)shm;
    LAS unsigned char* lds3 = (LAS unsigned char*)shm;
    pg8::StaticOrder S;
    if constexpr (PH == 0) phase0(p, ldsf);
    if constexpr (PH == 1) { pg8::Gemm g{(const bf16_t*)(p.ws + OFF_H), (const bf16_t*)(p.ws + OFF_BTIN), MTOK, NPAD, 1024}; S.init(g.M, g.N, (int)gridDim.x, (int)blockIdx.x);
                  EpiIn E{p.ws, p.out}; pg8::gemm_phase(lds3, g, S, E);
                  {
                      const int G = (int)gridDim.x, c = (int)blockIdx.x, nu = (MTOK / 256) * (NPAD / 256), nmax = (nu + G - 1) / G, first_short = nu - (nmax - 1) * G;
                      int ns = G - first_short, rank = c - first_short; if (ns <= 0) { ns = G; rank = c; }
                      if (rank >= 0) later_weight_tiles(p, ldsf, rank, ns);
                  } }
    if constexpr (PH == 2) phase2(p);
    if constexpr (PH == 3) { pg8::Gemm g{(const bf16_t*)(p.ws + OFF_AP), (const bf16_t*)(p.ws + OFF_BTS), MTOK, 1024, 256}; S.init(g.M, g.N, (int)gridDim.x, (int)blockIdx.x);
                  EpiSmall E{p.ws}; pg8::gemm_phase(lds3, g, S, E); }
    if constexpr (PH == 4) { for (int t = blockIdx.x; t < 256; t += gridDim.x) { if (t < 128) rwkv_scan(p, ldsf, t); else gdn_scan(p, ldsf, t - 128); } }
    if constexpr (PH == 5) phase35(p);
    if constexpr (PH == 6) { pg8::Gemm g{(const bf16_t*)(p.ws + OFF_QKV), (const bf16_t*)(p.ws + OFF_BTA), MTOK, 1024, 1024, (const bf16_t*)(p.ws + OFF_AA), 512, 8}; S.init(g.M, g.N, (int)gridDim.x, (int)blockIdx.x);
                  EpiAB E{p.ws, p.out}; pg8::gemm_phase(lds3, g, S, E); }
    if constexpr (PH == 8) { pg8::Gemm g{(const bf16_t*)(p.ws + OFF_GQKV), (const bf16_t*)(p.ws + OFF_BTO), MTOK, 1024, 1024}; S.init(g.M, g.N, (int)gridDim.x, (int)blockIdx.x);
                  EpiC3 E{p.x, p.out, (float*)(p.ws + OFF_RSS)}; pg8::gemm_phase(lds3, g, S, E); }
    if constexpr (PH == 9) phase6(p);
}
template <int PH> __global__ __launch_bounds__(512) void fwd_phase(Params p) {
    extern __shared__ __attribute__((aligned(16))) unsigned char shm[];
    run_phase<PH>(p, shm);
}
#ifndef N_LAUNCH_MODE
#define N_LAUNCH_MODE 1
#endif
#ifndef REPEAT_MASK
#define REPEAT_MASK 0
#endif
#ifndef MEGA_MASK
#define MEGA_MASK 1023
#endif
#if N_LAUNCH_MODE == 1
__global__ __launch_bounds__(512) void fwd_mega(Params p) {
    extern __shared__ __attribute__((aligned(16))) unsigned char shm[];
    cg::grid_group grid = cg::this_grid();
    if (threadIdx.x < 4) ((unsigned*)(shm + LDS_BYTES - 16))[threadIdx.x] = 0u;
    __syncthreads();
    XcdBarrier xb = xcd_barrier_post((unsigned*)(p.ws + OFF_BAR), (volatile LAS unsigned*)(shm + LDS_BYTES - 16));
#if (MEGA_MASK >> 0) & 1
    run_phase<0>(p, shm);
#endif
#if (REPEAT_MASK >> 0) & 1
    xcd_barrier(xb); run_phase<0>(p, shm);
#endif
    xcd_barrier(xb);
#if (MEGA_MASK >> 1) & 1
    run_phase<1>(p, shm);
#endif
#if (REPEAT_MASK >> 1) & 1
    xcd_barrier(xb); run_phase<1>(p, shm);
#endif
    xcd_barrier(xb);
#if (MEGA_MASK >> 2) & 1
    run_phase<2>(p, shm);
#endif
#if (REPEAT_MASK >> 2) & 1
    xcd_barrier(xb); run_phase<2>(p, shm);
#endif
    xcd_barrier(xb);
#if (MEGA_MASK >> 3) & 1
    run_phase<3>(p, shm);
#endif
#if (REPEAT_MASK >> 3) & 1
    xcd_barrier(xb); run_phase<3>(p, shm);
#endif
    xcd_barrier(xb);
#if (MEGA_MASK >> 4) & 1
    run_phase<4>(p, shm);
#endif
#if (REPEAT_MASK >> 4) & 1
    xcd_barrier(xb); run_phase<4>(p, shm);
#endif
    grid.sync();
#if (MEGA_MASK >> 5) & 1
    run_phase<5>(p, shm);
#endif
#if (REPEAT_MASK >> 5) & 1
    xcd_barrier(xb); run_phase<5>(p, shm);
#endif
    xcd_barrier(xb);
#if (MEGA_MASK >> 6) & 1
    run_phase<6>(p, shm);
#endif
#if (REPEAT_MASK >> 6) & 1
    xcd_barrier(xb); run_phase<6>(p, shm);
#endif
    xcd_barrier(xb);
#if (MEGA_MASK >> 8) & 1
    run_phase<8>(p, shm);
#endif
#if (REPEAT_MASK >> 8) & 1
    xcd_barrier(xb); run_phase<8>(p, shm);
#endif
    xcd_barrier(xb);
#if (MEGA_MASK >> 9) & 1
    run_phase<9>(p, shm);
#endif
#if (REPEAT_MASK >> 9) & 1
    xcd_barrier(xb); run_phase<9>(p, shm);
#endif
}
#endif

#ifndef N_LAUNCH_MODE
#define N_LAUNCH_MODE 1
#endif
template <int... I> static void set_attrs(std::integer_sequence<int, I...>) { ((void)hipFuncSetAttribute((const void*)fwd_phase<I>, hipFuncAttributeMaxDynamicSharedMemorySize, LDS_BYTES), ...); }
template <int... I> static void launch_all(std::integer_sequence<int, I...>, const Params& p, int grid, hipStream_t stream) { ((fwd_phase<I><<<dim3(grid), dim3(512), LDS_BYTES, stream>>>(p)), ...); }
extern "C" void kernel_launch(void* const* d_in, const int* in_sizes, int n_in, void* d_out, int out_size, void* d_ws, size_t ws_size, hipStream_t stream) {
    static int grid = 0;
    if (grid == 0) {
        if (n_in != 21 || ws_size < WS_END) { fprintf(stderr, "kernel_launch: unexpected n_in %d / ws %zu (need %zu)\n", n_in, ws_size, (size_t)WS_END); grid = -1; return; }
        int dev = 0, cus = 0, per_cu = 0;
        (void)hipGetDevice(&dev); (void)hipDeviceGetAttribute(&cus, hipDeviceAttributeMultiprocessorCount, dev);
#if N_LAUNCH_MODE == 1
        (void)hipFuncSetAttribute((const void*)fwd_mega, hipFuncAttributeMaxDynamicSharedMemorySize, LDS_BYTES);
        (void)hipOccupancyMaxActiveBlocksPerMultiprocessor(&per_cu, (const void*)fwd_mega, 512, LDS_BYTES);
#else
        set_attrs(std::make_integer_sequence<int, NPHASE>{});
        per_cu = 1;
#endif
        if (per_cu < 1) per_cu = 1;
        grid = cus * per_cu;
        (void)hipGetLastError();
    }
    if (grid < 0) return;
    Params p{};
    const float** dst = (const float**)&p;
    for (int i = 0; i < 21; ++i) dst[i] = (const float*)d_in[i];
    p.out = (float*)d_out; p.ws = (unsigned char*)d_ws;
#if N_LAUNCH_MODE == 1
    (void)hipMemsetAsync((char*)d_ws + OFF_BAR, 0, 16384, stream);
    void* args[] = {&p};
    hipError_t e = hipLaunchCooperativeKernel((const void*)fwd_mega, dim3(grid), dim3(512), args, LDS_BYTES, stream);
    if (e != hipSuccess) fprintf(stderr, "cooperative launch failed: %s (grid %d)\n", hipGetErrorString(e), grid);
#else
    launch_all(std::make_integer_sequence<int, NPHASE>{}, p, grid, stream);
#endif
}
```

```cpp
#include <hip/hip_runtime.h>
#include <hip/hip_cooperative_groups.h>
#include <cstdio>
#include <utility>
namespace cg = cooperative_groups;
namespace pg8 {
#define PG8_LAS __attribute__((address_space(3)))
typedef unsigned short bf16_t;
typedef short bf16x8 __attribute__((ext_vector_type(8)));
typedef float f32x4 __attribute__((ext_vector_type(4)));
typedef unsigned u32x4 __attribute__((ext_vector_type(4)));
constexpr int BM = 256, BK = 64, HALF = 128, HTB = HALF * BK * 2  , STAGE_BYTES = 8 * HTB, NXCD = 8, WGM = 8;

__host__ __device__ __forceinline__ int lds_byte(int r, int c) { const int st = (r >> 4) * 2 + (c >> 5), rr = r & 15, cc = c & 31, ob = rr * 64 + cc * 2; return st * 1024 + (ob ^ (((ob >> 9) & 1) << 5)); }
__host__ __device__ __forceinline__ void stage_rc(int b, int& R, int& C) { const int st = b / 1024, sb = b % 1024, swz = sb ^ (((sb >> 9) & 1) << 5); R = (st >> 1) * 16 + swz / 64; C = (st & 1) * 32 + (swz % 64) / 2; }
__host__ __device__ __forceinline__ int perm32(int rho) { const int n = rho >> 4, i = rho & 15; return 8 * (i >> 2) + 4 * n + (i & 3); }


struct Unit { int pm, pn; };
struct Gemm { const bf16_t* A; const bf16_t* Bt; int M, N, K; const bf16_t* A2; int lda, ksplit; };
struct StaticOrder {
    int nM, nN, nwg, G, c;
    __host__ __device__ void init(int M, int N, int G_, int c_) { nM = M / BM; nN = N / BM; nwg = nM * nN; G = G_; c = c_; }
    __host__ __device__ bool next(int i, Unit& u) const {
        const long L = (long)i * G + c; if (L >= nwg) return false;
        int wgid = (int)L; { const int q = nwg / NXCD, r = nwg % NXCD, xcd = wgid % NXCD, off = wgid / NXCD; wgid = (xcd < r ? xcd * (q + 1) : r * (q + 1) + (xcd - r) * q) + off; }
        const int nig = WGM * nN, gid = wgid / nig, fm = gid * WGM, gsz = (nM - fm) < WGM ? (nM - fm) : WGM;
        u.pm = fm + ((wgid % nig) % gsz); u.pn = (wgid % nig) / gsz; return true;
    }
    __device__ __forceinline__ void a_ready(const Unit&) const {}
    __device__ __forceinline__ void done(const Unit&) const {}
};
__device__ __forceinline__ unsigned cvt_pk_bf16(float lo, float hi) { unsigned r; asm volatile("v_cvt_pk_bf16_f32 %0, %1, %2" : "=v"(r) : "v"(lo), "v"(hi)); return r; }
template <class Epi, class Sched>
__device__ __forceinline__ void gemm_phase(PG8_LAS unsigned char* lds, const Gemm g, const Sched& S, const Epi& E) {
    int tid_ = threadIdx.x; asm volatile("" : "+v"(tid_));
    const int tid = tid_, wid = __builtin_amdgcn_readfirstlane(tid >> 6), lane = tid & 63, wr = wid >> 2, wc = wid & 3, fr = lane & 15, fq = lane >> 4;
    int K_ = g.K; asm volatile("" : "+s"(K_));
    const int K = K_, nt = K / BK;
    const int lda = Epi::SPLIT_A ? g.lda : K, ksplit = Epi::SPLIT_A ? g.ksplit : 0;
    unsigned voffA[2], voffB[2];
#pragma unroll
    for (int i = 0; i < 2; ++i) { int R, C; stage_rc(tid * 16 + i * 8192, R, C); const int Rb = Epi::PERM ? ((R & ~31) + perm32(R & 31)) : R;
        voffA[i] = (unsigned)(R * lda + C) * 2u; voffB[i] = (unsigned)(Rb * K + C) * 2u; }
    const size_t kstep = (size_t)(BK * 2);
    const size_t hstep = (size_t)HALF * K * 2;
    const size_t tstep = 2 * hstep;
    const size_t hstepA = (size_t)HALF * lda * 2, tstepA = 2 * hstepA;
    const unsigned ldsw = (unsigned)wid * 1024u;
    const int aoff = lds_byte(wr * 64 + fr, fq * 8), boff = lds_byte(wc * 32 + fr, fq * 8);
#define PG8_SA(b, h) (((b) * 2 + (h)) * HTB)
#define PG8_SB(b, h) ((4 + (b) * 2 + (h)) * HTB)
#define PG8_STAGE(bufoff, gbase, voff) do { _Pragma("unroll") for (int _i = 0; _i < 2; ++_i) \
        __builtin_amdgcn_global_load_lds((const unsigned*)((const char*)(gbase) + (voff)[_i]), (PG8_LAS unsigned*)(lds + (bufoff) + ldsw + _i * 8192), 16, 0, 0); } while (0)
#define PG8_LDA(dst, b, h) do { _Pragma("unroll") for (int m = 0; m < 4; ++m) _Pragma("unroll") for (int k = 0; k < 2; ++k) dst[m][k] = *(const PG8_LAS bf16x8*)(lds + PG8_SA(b, h) + aoff + m * 2048 + k * 1024); } while (0)
#define PG8_LDB(dst, b, h) do { _Pragma("unroll") for (int n = 0; n < 2; ++n) _Pragma("unroll") for (int k = 0; k < 2; ++k) dst[n][k] = *(const PG8_LAS bf16x8*)(lds + PG8_SB(b, h) + boff + n * 2048 + k * 1024); } while (0)
#define PG8_MMA(ai, bj, At, Bt) do { __builtin_amdgcn_s_setprio(1); _Pragma("unroll") for (int m = 0; m < 4; ++m) _Pragma("unroll") for (int n = 0; n < 2; ++n) _Pragma("unroll") for (int k = 0; k < 2; ++k) \
        acc[ai][bj][m][n] = __builtin_amdgcn_mfma_f32_16x16x32_bf16(Bt[n][k], At[m][k], acc[ai][bj][m][n], 0, 0, 0); __builtin_amdgcn_s_setprio(0); } while (0)
#define PG8_WAIT_V(n) asm volatile("s_waitcnt vmcnt(" #n ")" ::: "memory")
#define PG8_WAIT_L(n) asm volatile("s_waitcnt lgkmcnt(" #n ")" ::: "memory")
#define PG8_BAR __builtin_amdgcn_s_barrier()
#define PG8_SCHED __builtin_amdgcn_sched_barrier(0)
    Unit cur, nxt; int ui = 0;
    if (!S.next(0, cur)) return;
    f32x4 acc[2][2][4][2];
#pragma unroll
    for (int a = 0; a < 2; ++a)
#pragma unroll
        for (int b = 0; b < 2; ++b)
#pragma unroll
            for (int m = 0; m < 4; ++m)
#pragma unroll
                for (int n = 0; n < 2; ++n) acc[a][b][m][n] = (f32x4){0.f, 0.f, 0.f, 0.f};
    bf16x8 At[4][2], B0[2][2], B1[2][2];
    const char* cA = (const char*)g.A + (size_t)cur.pm * tstepA; const char* cB = (const char*)g.Bt + (size_t)cur.pn * tstep;
    const char* cA2 = Epi::SPLIT_A ? (const char*)g.A2 + (size_t)cur.pm * tstepA : cA;
    S.a_ready(cur);
    PG8_STAGE(PG8_SB(0, 0), cB, voffB); PG8_STAGE(PG8_SA(0, 0), cA, voffA); PG8_STAGE(PG8_SB(0, 1), cB + hstep, voffB); PG8_STAGE(PG8_SA(0, 1), cA + hstepA, voffA);
    if (wr == 1) PG8_BAR;
    PG8_WAIT_V(4); PG8_BAR;
    PG8_STAGE(PG8_SB(1, 0), cB + kstep, voffB); PG8_STAGE(PG8_SA(1, 0), cA + kstep, voffA); PG8_STAGE(PG8_SB(1, 1), cB + hstep + kstep, voffB);
    PG8_WAIT_V(6); PG8_BAR;
    for (;;) {
        const bool has_next = S.next(ui + 1, nxt);
        const char* nA = has_next ? (const char*)g.A + (size_t)nxt.pm * tstepA : cA; const char* nB = has_next ? (const char*)g.Bt + (size_t)nxt.pn * tstep : cB;
        const char* nA2 = (Epi::SPLIT_A && has_next) ? (const char*)g.A2 + (size_t)nxt.pm * tstepA : cA2;
        for (int t = 0; t < nt; t += 2) {
            const bool last = (t == nt - 2);
            const char* a1 = (Epi::SPLIT_A && t + 1 >= ksplit) ? cA2 + (size_t)(t + 1 - ksplit) * kstep : cA + (size_t)(t + 1) * kstep;
            const char* a2 = last ? nA : ((Epi::SPLIT_A && t + 2 >= ksplit) ? cA2 + (size_t)(t + 2 - ksplit) * kstep : cA + (size_t)(t + 2) * kstep); const char* b2 = last ? nB : cB + (size_t)(t + 2) * kstep;
            const char* a3 = a2 + kstep; const char* b3 = b2 + kstep;
            if (last && has_next) S.a_ready(nxt);
            if constexpr (Epi::SPLIT_A) { if (t == ksplit) E.mid(acc, cur, wr, wc, fr, fq); }
            PG8_LDB(B0, 0, 0); PG8_SCHED; PG8_LDA(At, 0, 0); PG8_STAGE(PG8_SA(1, 1), a1 + hstepA, voffA);
            PG8_WAIT_L(8); PG8_BAR; PG8_WAIT_L(0); PG8_MMA(0, 0, At, B0); PG8_BAR; PG8_SCHED;
            PG8_LDB(B1, 0, 1); PG8_STAGE(PG8_SB(0, 0), b2, voffB);
            PG8_BAR; PG8_WAIT_L(0); PG8_MMA(0, 1, At, B1); PG8_BAR;
            PG8_LDA(At, 0, 1); PG8_STAGE(PG8_SA(0, 0), a2, voffA);
            PG8_BAR; PG8_WAIT_L(0); PG8_MMA(1, 0, At, B0); PG8_BAR; PG8_SCHED;
            PG8_STAGE(PG8_SB(0, 1), b2 + hstep, voffB);
            PG8_WAIT_V(6); PG8_BAR; PG8_MMA(1, 1, At, B1); PG8_BAR;
            PG8_LDB(B0, 1, 0); PG8_SCHED; PG8_LDA(At, 1, 0); PG8_STAGE(PG8_SA(0, 1), a2 + hstepA, voffA);
            PG8_WAIT_L(8); PG8_BAR; PG8_WAIT_L(0); PG8_MMA(0, 0, At, B0); PG8_BAR; PG8_SCHED;
            PG8_LDB(B1, 1, 1); PG8_STAGE(PG8_SB(1, 0), b3, voffB);
            PG8_BAR; PG8_WAIT_L(0); PG8_MMA(0, 1, At, B1); PG8_BAR;
            PG8_LDA(At, 1, 1); PG8_STAGE(PG8_SA(1, 0), a3, voffA);
            PG8_BAR; PG8_WAIT_L(0); PG8_MMA(1, 0, At, B0); PG8_BAR; PG8_SCHED;
            PG8_STAGE(PG8_SB(1, 1), b3 + hstep, voffB);
            PG8_WAIT_V(6); PG8_BAR; PG8_MMA(1, 1, At, B1); PG8_BAR;
        }
        if constexpr (!Epi::AFTER_DRAIN) { E(acc, cur, wr, wc, fr, fq); S.done(cur); }
        if (!has_next) break;
#pragma unroll
        for (int a = 0; a < 2; ++a)
#pragma unroll
            for (int b = 0; b < 2; ++b)
#pragma unroll
                for (int m = 0; m < 4; ++m)
#pragma unroll
                    for (int n = 0; n < 2; ++n) acc[a][b][m][n] = (f32x4){0.f, 0.f, 0.f, 0.f};
        cur = nxt; cA = nA; cA2 = nA2; cB = nB; ++ui;
    }
    PG8_WAIT_V(0);
    if (wr == 0) PG8_BAR;
    PG8_BAR;
    if constexpr (Epi::AFTER_DRAIN) { E.fused(acc, cur, wr, wc, fr, fq, lds, wid, lane); S.done(cur); }
#undef PG8_SA
#undef PG8_SB
#undef PG8_STAGE
#undef PG8_LDA
#undef PG8_LDB
#undef PG8_MMA
#undef PG8_WAIT_V
#undef PG8_WAIT_L
#undef PG8_BAR
#undef PG8_SCHED
}
}

using pg8::bf16_t; using pg8::f32x4; using pg8::u32x4; using pg8::Unit;
#define LAS __attribute__((address_space(3)))

constexpr int MTOK = 32768, DM = 1024, TSEQ = 2048, NB = 16;
constexpr int INC = 6280, NPAD = 6400;
constexpr int LDS_BYTES = 163840;
constexpr size_t OFF_H    = 0;
constexpr size_t OFF_BT   = OFF_H + 67108864ull;
constexpr size_t OFF_BTIN = OFF_BT;
constexpr size_t OFF_BTA  = OFF_BTIN + 13107200ull;
constexpr size_t OFF_BTB  = OFF_BTA + 1048576ull;
constexpr size_t OFF_BTO  = OFF_BTB + 1048576ull;
constexpr size_t OFF_BTS  = OFF_BTO + 2097152ull;
constexpr size_t OFF_RSS  = OFF_BTS + 524288ull;
constexpr size_t OFF_PRKV = OFF_RSS + 131072ull;
constexpr size_t OFF_PX   = OFF_PRKV + 100663296ull;
constexpr size_t OFF_ZRW  = OFF_PX + 17825792ull;
constexpr size_t OFF_QKV  = OFF_ZRW + 33554432ull;
constexpr size_t OFF_ZGD  = OFF_QKV + 100663296ull;
constexpr size_t OFF_AP   = OFF_ZGD + 33554432ull;
constexpr size_t OFF_AA   = OFF_AP + 16777216ull;
constexpr size_t OFF_GQKV = OFF_AA + 33554432ull;
constexpr size_t OFF_BAR  = OFF_GQKV + 100663296ull;
constexpr size_t WS_END   = OFF_BAR + 16384ull;

struct Params {
    const float *x, *norm_in_w, *w_in, *rw_mu, *rw_w0, *rw_w2, *rw_a0, *rw_a2, *rw_k_k, *rw_k_a, *rw_r_k, *rw_gn_w, *rw_gn_b,
                *gd_conv_w, *gd_A_log, *gd_dt_bias, *gd_o_norm_w, *w_branch_a, *w_branch_b, *w_out, *norm_out_w;
    float* out; unsigned char* ws;
    int pad0, pad1;
};

__device__ __forceinline__ int otid() { int t = threadIdx.x; asm volatile("" : "+v"(t)); return t; }
__device__ __forceinline__ float bf2f(bf16_t v) { return __uint_as_float(((unsigned)v) << 16); }
__device__ __forceinline__ bf16_t f2bf(float f) { unsigned u = __float_as_uint(f); u += 0x7FFFu + ((u >> 16) & 1u); return (bf16_t)(u >> 16); }
__device__ __forceinline__ unsigned pk2(float lo, float hi) { return pg8::cvt_pk_bf16(lo, hi); }
__device__ __forceinline__ float wave_sum(float v) {
    v += __int_as_float(__builtin_amdgcn_update_dpp(0, __float_as_int(v), 0xB1, 0xF, 0xF, true));
    v += __int_as_float(__builtin_amdgcn_update_dpp(0, __float_as_int(v), 0x4E, 0xF, 0xF, true));
    v += __int_as_float(__builtin_amdgcn_update_dpp(0, __float_as_int(v), 0x141, 0xF, 0xF, true));
    v += __int_as_float(__builtin_amdgcn_update_dpp(0, __float_as_int(v), 0x140, 0xF, 0xF, true));
    const int iv = __float_as_int(v);
    return (__int_as_float(__builtin_amdgcn_readlane(iv, 0)) + __int_as_float(__builtin_amdgcn_readlane(iv, 16))) + (__int_as_float(__builtin_amdgcn_readlane(iv, 32)) + __int_as_float(__builtin_amdgcn_readlane(iv, 48)));
}
__device__ __forceinline__ float row_sum16(float v) {
    v += __int_as_float(__builtin_amdgcn_update_dpp(0, __float_as_int(v), 0xB1, 0xF, 0xF, true));
    v += __int_as_float(__builtin_amdgcn_update_dpp(0, __float_as_int(v), 0x4E, 0xF, 0xF, true));
    v += __int_as_float(__builtin_amdgcn_update_dpp(0, __float_as_int(v), 0x141, 0xF, 0xF, true));
    v += __int_as_float(__builtin_amdgcn_update_dpp(0, __float_as_int(v), 0x140, 0xF, 0xF, true));
    return v;
}
#define LD4(ptr) (*(const f32x4*)(ptr))
#define PIN() asm volatile("" ::: "memory")
__device__ __forceinline__ float sigmoidf_(float v) { return __builtin_amdgcn_rcpf(1.f + __expf(-v)); }
__device__ __forceinline__ float softplusf_(float v) { return fmaxf(v, 0.f) + log1pf(__expf(-fabsf(v))); }
__device__ __forceinline__ void unpack8(const u32x4 w, float (&f)[8]) {
    f[0] = __uint_as_float(w.x << 16); f[1] = __uint_as_float(w.x & 0xffff0000u); f[2] = __uint_as_float(w.y << 16); f[3] = __uint_as_float(w.y & 0xffff0000u);
    f[4] = __uint_as_float(w.z << 16); f[5] = __uint_as_float(w.z & 0xffff0000u); f[6] = __uint_as_float(w.w << 16); f[7] = __uint_as_float(w.w & 0xffff0000u);
}
__device__ __forceinline__ u32x4 pack8(const float (&f)[8]) { u32x4 w; w.x = pk2(f[0], f[1]); w.y = pk2(f[2], f[3]); w.z = pk2(f[4], f[5]); w.w = pk2(f[6], f[7]); return w; }


#define EPI_LOOP(...) \
    const int row0 = u.pm * 256 + wr * 64 + fr, col0 = u.pn * 256 + wc * 32 + 8 * fq; \
    _Pragma("unroll") for (int ai = 0; ai < 2; ++ai) _Pragma("unroll") for (int m = 0; m < 4; ++m) _Pragma("unroll") for (int bj = 0; bj < 2; ++bj) { \
        const int row = row0 + ai * 128 + m * 16, col = col0 + bj * 128; \
        const float v[8] = {acc[ai][bj][m][0][0], acc[ai][bj][m][0][1], acc[ai][bj][m][0][2], acc[ai][bj][m][0][3], acc[ai][bj][m][1][0], acc[ai][bj][m][1][1], acc[ai][bj][m][1][2], acc[ai][bj][m][1][3]}; \
        __VA_ARGS__ }
struct EpiIn {
    static constexpr bool PERM = true, AFTER_DRAIN = false, SPLIT_A = false;
    unsigned char* ws; float* gates;
    __device__ __forceinline__ void operator()(const f32x4 (&acc)[2][2][4][2], const Unit& u, int wr, int wc, int fr, int fq) const {
        const int pn = u.pn;
        if (pn == 6) {
            float* base = (float*)(ws + OFF_PX);
            EPI_LOOP( const int c = col - 1536; if (c < 136) { float* d = base + (size_t)row * 136 + c; *(f32x4*)d = (f32x4){v[0], v[1], v[2], v[3]}; *(f32x4*)(d + 4) = (f32x4){v[4], v[5], v[6], v[7]}; } )
        } else {
            bf16_t* base; int ld, coff;
            if (pn < 6) { base = (bf16_t*)(ws + OFF_PRKV); ld = 1536; coff = 0; }
            else if (pn < 9) { base = (bf16_t*)(ws + OFF_ZRW); ld = 512; coff = 1792; }
            else if (pn < 15) { base = (bf16_t*)(ws + OFF_QKV); ld = 1536; coff = 2304; }
            else if (pn < 17) { base = (bf16_t*)(ws + OFF_ZGD); ld = 512; coff = 3840; }
            else { base = (bf16_t*)gates; ld = 2048; coff = 4352; }
            EPI_LOOP( *(u32x4*)(base + (size_t)row * ld + (col - coff)) = pack8(v); )
        }
    }
};
struct EpiSmall {
    static constexpr bool PERM = true, AFTER_DRAIN = false, SPLIT_A = false;
    unsigned char* ws;
    __device__ __forceinline__ void operator()(const f32x4 (&acc)[2][2][4][2], const Unit& u, int wr, int wc, int fr, int fq) const {
        if (u.pn < 2) {
            float* base = (float*)(ws + OFF_H);
            EPI_LOOP( float* d = base + (size_t)row * 512 + col; *(f32x4*)d = (f32x4){v[0], v[1], v[2], v[3]}; *(f32x4*)(d + 4) = (f32x4){v[4], v[5], v[6], v[7]}; )
        } else {
            bf16_t* base = (bf16_t*)(ws + OFF_AA);
            EPI_LOOP( *(u32x4*)(base + (size_t)row * 512 + (col - 512)) = pack8(v); )
        }
    }
};
struct EpiC1 {
    static constexpr bool PERM = true, AFTER_DRAIN = false, SPLIT_A = false;
    unsigned char* ws; const float* gates;
    __device__ __forceinline__ void operator()(const f32x4 (&acc)[2][2][4][2], const Unit& u, int wr, int wc, int fr, int fq) const {
        const bf16_t* gb = (const bf16_t*)gates; bf16_t* m1b = (bf16_t*)(ws + OFF_PRKV);
        EPI_LOOP( float g[8], o[8]; unpack8(*(const u32x4*)(gb + (size_t)row * 2048 + col), g);
            _Pragma("unroll") for (int j = 0; j < 8; ++j) o[j] = sigmoidf_(g[j]) * v[j];
            *(u32x4*)(m1b + (size_t)row * 1024 + col) = pack8(o); )
    }
};
struct EpiC2 {
    static constexpr bool PERM = true, AFTER_DRAIN = false, SPLIT_A = false;
    unsigned char* ws; const float* gates;
    __device__ __forceinline__ void operator()(const f32x4 (&acc)[2][2][4][2], const Unit& u, int wr, int wc, int fr, int fq) const {
        const bf16_t* gb = (const bf16_t*)gates + 1024; const bf16_t* m1b = (const bf16_t*)(ws + OFF_PRKV); bf16_t* mg = (bf16_t*)(ws + OFF_GQKV);
        EPI_LOOP( float g[8], m1[8], o[8]; unpack8(*(const u32x4*)(gb + (size_t)row * 2048 + col), g); unpack8(*(const u32x4*)(m1b + (size_t)row * 1024 + col), m1);
            _Pragma("unroll") for (int j = 0; j < 8; ++j) o[j] = m1[j] + sigmoidf_(g[j]) * v[j];
            *(u32x4*)(mg + (size_t)row * 1024 + col) = pack8(o); )
    }
};
struct EpiAB {
    static constexpr bool PERM = true, AFTER_DRAIN = false, SPLIT_A = true;
    unsigned char* ws; const float* gates;
    __device__ __forceinline__ void mid(f32x4 (&acc)[2][2][4][2], const Unit& u, int wr, int wc, int fr, int fq) const {
        asm volatile("" : "+v"(fr), "+v"(fq));
        const bf16_t* gb = (const bf16_t*)gates;
        const int row0 = u.pm * 256 + wr * 64 + fr, col0 = u.pn * 256 + wc * 32 + 8 * fq;
#pragma unroll
        for (int ai = 0; ai < 2; ++ai)
#pragma unroll
            for (int mp = 0; mp < 1; ++mp) {
                u32x4 ra[4][2], rb[4][2];
#pragma unroll
                for (int mm = 0; mm < 4; ++mm)
#pragma unroll
                    for (int bj = 0; bj < 2; ++bj) { const size_t o = (size_t)(row0 + ai * 128 + (mp * 4 + mm) * 16) * 2048 + col0 + bj * 128; ra[mm][bj] = *(const u32x4*)(gb + o); rb[mm][bj] = *(const u32x4*)(gb + o + 1024); }
                PIN();
#pragma unroll
                for (int mm = 0; mm < 4; ++mm)
#pragma unroll
                    for (int bj = 0; bj < 2; ++bj) {
                        float ga[8], gv[8]; unpack8(ra[mm][bj], ga); unpack8(rb[mm][bj], gv);
                        const int m = mp * 4 + mm;
#pragma unroll
                        for (int j = 0; j < 4; ++j) {
                            acc[ai][bj][m][0][j] *= sigmoidf_(ga[j]) * (1.f + __expf(fminf(-gv[j], 80.f)));
                            acc[ai][bj][m][1][j] *= sigmoidf_(ga[4 + j]) * (1.f + __expf(fminf(-gv[4 + j], 80.f)));
                        }
                    }
                PIN();
            }
    }
    __device__ __forceinline__ void operator()(const f32x4 (&acc)[2][2][4][2], const Unit& u, int wr, int wc, int fr, int fq) const {
        asm volatile("" : "+v"(fr), "+v"(fq));
        const bf16_t* gb = (const bf16_t*)gates + 1024; bf16_t* mg = (bf16_t*)(ws + OFF_GQKV);
        const int row0 = u.pm * 256 + wr * 64 + fr, col0 = u.pn * 256 + wc * 32 + 8 * fq;
#pragma unroll
        for (int ai = 0; ai < 2; ++ai)
#pragma unroll
            for (int mp = 0; mp < 1; ++mp) {
                u32x4 rg[4][2];
#pragma unroll
                for (int mm = 0; mm < 4; ++mm)
#pragma unroll
                    for (int bj = 0; bj < 2; ++bj) rg[mm][bj] = *(const u32x4*)(gb + (size_t)(row0 + ai * 128 + (mp * 4 + mm) * 16) * 2048 + col0 + bj * 128);
                PIN();
#pragma unroll
                for (int mm = 0; mm < 4; ++mm)
#pragma unroll
                    for (int bj = 0; bj < 2; ++bj) {
                        const int m = mp * 4 + mm; float g[8], o[8]; unpack8(rg[mm][bj], g);
#pragma unroll
                        for (int j = 0; j < 4; ++j) { o[j] = sigmoidf_(g[j]) * acc[ai][bj][m][0][j]; o[4 + j] = sigmoidf_(g[4 + j]) * acc[ai][bj][m][1][j]; }
                        *(u32x4*)(mg + (size_t)(row0 + ai * 128 + m * 16) * 1024 + col0 + bj * 128) = pack8(o);
                    }
                PIN();
            }
    }
};
struct EpiC3 {
    static constexpr bool PERM = true, AFTER_DRAIN = false, SPLIT_A = false;
    const float* x; float* out; float* rss;
    __device__ __forceinline__ void operator()(const f32x4 (&acc)[2][2][4][2], const Unit& u, int wr, int wc, int fr, int fq) const {
        asm volatile("" : "+v"(fr), "+v"(fq));
        const int row0 = u.pm * 256 + wr * 64 + fr, col0 = u.pn * 256 + wc * 32 + 8 * fq;
#pragma unroll
        for (int ai = 0; ai < 2; ++ai)
#pragma unroll
            for (int mp = 0; mp < 1; ++mp) {
                f32x4 xa[4][2], xb[4][2];
#pragma unroll
                for (int mm = 0; mm < 4; ++mm)
#pragma unroll
                    for (int bj = 0; bj < 2; ++bj) { const size_t o = (size_t)(row0 + ai * 128 + (mp * 4 + mm) * 16) * 1024 + col0 + bj * 128; xa[mm][bj] = *(const f32x4*)(x + o); xb[mm][bj] = *(const f32x4*)(x + o + 4); }
                PIN();
#pragma unroll
                for (int mm = 0; mm < 4; ++mm) {
                    const int m = mp * 4 + mm, row = row0 + ai * 128 + m * 16; float ss = 0.f;
#pragma unroll
                    for (int bj = 0; bj < 2; ++bj) {
                        const size_t o = (size_t)row * 1024 + col0 + bj * 128;
                        const f32x4 a = xa[mm][bj] + acc[ai][bj][m][0], b = xb[mm][bj] + acc[ai][bj][m][1];
                        *(f32x4*)(out + o) = a; *(f32x4*)(out + o + 4) = b;
                        ss += a[0] * a[0] + a[1] * a[1] + a[2] * a[2] + a[3] * a[3] + b[0] * b[0] + b[1] * b[1] + b[2] * b[2] + b[3] * b[3];
                    }
                    ss += __shfl_xor(ss, 16); ss += __shfl_xor(ss, 32);
                    if (fq == 0) atomicAdd(rss + row, ss);
                }
                PIN();
            }
    }
};

__device__ __forceinline__ int in_src_col(int n) {
    if (n < 1664) return n;
    if (n < 1672) return 4224 + (n - 1664);
    if (n < 1792) return -1;
    if (n < 2304) return 1664 + (n - 1792);
    if (n < 3840) return 2176 + (n - 2304);
    if (n < 4352) return 3712 + (n - 3840);
    return 4232 + (n - 4352);
}
template <int WHICH> __device__ __forceinline__ float wsrc(const Params& p, int n, int k) {
    if (WHICH == 0) { const int s = in_src_col(n); return s >= 0 ? p.w_in[(size_t)k * INC + s] : 0.f; }
    if (WHICH == 1) return k < 512 ? p.w_branch_a[(size_t)k * 1024 + n] : p.w_branch_b[(size_t)(k - 512) * 1024 + n];
    if (WHICH == 3) return p.w_out[(size_t)k * 1024 + n];
    if (n < 512) return k < 64 ? p.rw_w2[k * 512 + n] : 0.f;
    return (k >= 64 && k < 128) ? p.rw_a2[(k - 64) * 512 + (n - 512)] : 0.f;
}
template <int WHICH> __device__ __forceinline__ void transpose_tile(const Params& p, float* lds, bf16_t* Bt, int K, int n0, int k0) {
    const int tid = otid(), c = tid & 63, r = tid >> 6;
    float v[8];
#pragma unroll
    for (int q = 0; q < 8; ++q) v[q] = wsrc<WHICH>(p, n0 + c, k0 + r + 8 * q);
    __syncthreads();
#pragma unroll
    for (int q = 0; q < 8; ++q) lds[(r + 8 * q) * 65 + c] = v[q];
    __syncthreads();
#pragma unroll
    for (int q = 0; q < 8; ++q) Bt[(size_t)(n0 + r + 8 * q) * K + k0 + c] = f2bf(lds[c * 65 + r + 8 * q]);
}
__device__ void phase0(const Params& p, float* lds) {
    const int tid = otid(), lane = tid & 63, gw = blockIdx.x * 8 + (tid >> 6), nw = gridDim.x * 8;
    bf16_t* H = (bf16_t*)(p.ws + OFF_H);
    f32x4 gq[4];
#pragma unroll
    for (int i = 0; i < 4; ++i) gq[i] = *(const f32x4*)(p.norm_in_w + lane * 16 + i * 4);
    for (int r0 = gw; r0 < MTOK; r0 += 4 * nw) {
        f32x4 a[4][4];
#pragma unroll
        for (int q = 0; q < 4; ++q) { const int row = min(r0 + q * nw, MTOK - 1);
#pragma unroll
            for (int i = 0; i < 4; ++i) a[q][i] = *(const f32x4*)(p.x + (size_t)row * 1024 + lane * 16 + i * 4); }
        PIN();
#pragma unroll
        for (int q = 0; q < 4; ++q) {
            const int row = r0 + q * nw; if (row >= MTOK) break;
            float ss = 0.f;
#pragma unroll
            for (int i = 0; i < 4; ++i) ss += a[q][i][0] * a[q][i][0] + a[q][i][1] * a[q][i][1] + a[q][i][2] * a[q][i][2] + a[q][i][3] * a[q][i][3];
            ss = wave_sum(ss);
            const float rs = rsqrtf(ss * (1.f / 1024.f) + 1e-6f);
            float o[16];
#pragma unroll
            for (int i = 0; i < 4; ++i)
#pragma unroll
                for (int j = 0; j < 4; ++j) o[i * 4 + j] = a[q][i][j] * rs * gq[i][j];
            u32x4 w0, w1; w0.x = pk2(o[0], o[1]); w0.y = pk2(o[2], o[3]); w0.z = pk2(o[4], o[5]); w0.w = pk2(o[6], o[7]);
            w1.x = pk2(o[8], o[9]); w1.y = pk2(o[10], o[11]); w1.z = pk2(o[12], o[13]); w1.w = pk2(o[14], o[15]);
            *(u32x4*)(H + (size_t)row * 1024 + lane * 16) = w0; *(u32x4*)(H + (size_t)row * 1024 + lane * 16 + 8) = w1;
        }
    }
    for (int t = blockIdx.x; t < 2176; t += gridDim.x) {
        if (t < 1600) transpose_tile<0>(p, lds, (bf16_t*)(p.ws + OFF_BTIN), 1024, (t >> 4) * 64, (t & 15) * 64);
        else if (t < 1856) { const int u = t - 1600; transpose_tile<1>(p, lds, (bf16_t*)(p.ws + OFF_BTA), 1024, (u >> 4) * 64, (u & 15) * 64); }
        else if (t < 2112) { const int u = t - 1856; transpose_tile<3>(p, lds, (bf16_t*)(p.ws + OFF_BTO), 1024, (u >> 4) * 64, (u & 15) * 64); }
        else { const int u = t - 2112; transpose_tile<4>(p, lds, (bf16_t*)(p.ws + OFF_BTS), 256, (u >> 2) * 64, (u & 3) * 64); }
    }
    float* rss = (float*)(p.ws + OFF_RSS);
    for (int i = blockIdx.x * 512 + tid; i < MTOK; i += gridDim.x * 512) rss[i] = 0.f;
}

__device__ void phase2(const Params& p) {
    const int tid = otid(), lane = tid & 63;
    const float* PX = (const float*)(p.ws + OFF_PX);
    bf16_t* AP = (bf16_t*)(p.ws + OFF_AP);
    for (int task = blockIdx.x * 512 + tid; task < (MTOK / 16) * 128; task += gridDim.x * 512) {
        const int j = task & 127, m0 = (task >> 7) * 16;
        float v[17];
        v[0] = (m0 & (TSEQ - 1)) ? PX[(size_t)(m0 - 1) * 136 + j] : 0.f;
#pragma unroll
        for (int t = 0; t < 16; ++t) v[t + 1] = PX[(size_t)(m0 + t) * 136 + j];
        PIN();
        const float mu = p.rw_mu[1536 + j];
#pragma unroll
        for (int t = 0; t < 16; ++t) {
            float xs = v[t + 1] + (v[t] - v[t + 1]) * mu;
            if (j < 64) xs = tanhf(xs);
            AP[(size_t)(m0 + t) * 256 + j] = f2bf(xs); AP[(size_t)(m0 + t) * 256 + 128 + j] = 0;
        }
    }
    const bf16_t* QKV = (const bf16_t*)(p.ws + OFF_QKV);
    bf16_t* GQ = (bf16_t*)(p.ws + OFF_GQKV);
    const int gw = blockIdx.x * 8 + (tid >> 6), nw = gridDim.x * 8;
    for (int task = gw; task < (MTOK / 16) * 3; task += nw) {
        const int grp = task % 3, m0 = (task / 3) * 16;
        const int ch = grp * 512 + lane * 8;
        float cw[4][8];
#pragma unroll
        for (int i = 0; i < 4; ++i) { const f32x4 a = *(const f32x4*)(p.gd_conv_w + i * 1536 + ch), b = *(const f32x4*)(p.gd_conv_w + i * 1536 + ch + 4);
#pragma unroll
            for (int j = 0; j < 4; ++j) { cw[i][j] = a[j]; cw[i][4 + j] = b[j]; } }
        float x1[8], x2[8], x3[8];
        if (m0 & (TSEQ - 1)) {
            unpack8(*(const u32x4*)(QKV + (size_t)(m0 - 1) * 1536 + ch), x1); unpack8(*(const u32x4*)(QKV + (size_t)(m0 - 2) * 1536 + ch), x2); unpack8(*(const u32x4*)(QKV + (size_t)(m0 - 3) * 1536 + ch), x3);
        } else {
#pragma unroll
            for (int j = 0; j < 8; ++j) { x1[j] = 0.f; x2[j] = 0.f; x3[j] = 0.f; }
        }
        u32x4 raw[16];
#pragma unroll
        for (int t = 0; t < 16; ++t) raw[t] = *(const u32x4*)(QKV + (size_t)(m0 + t) * 1536 + ch);
        PIN();
#pragma unroll
        for (int t = 0; t < 16; ++t) {
            const int m = m0 + t; float x0[8], y[8]; unpack8(raw[t], x0);
            float ss = 0.f;
#pragma unroll
            for (int j = 0; j < 8; ++j) { const float c = cw[0][j] * x3[j] + cw[1][j] * x2[j] + cw[2][j] * x1[j] + cw[3][j] * x0[j]; y[j] = c * sigmoidf_(c); ss += y[j] * y[j]; x3[j] = x2[j]; x2[j] = x1[j]; x1[j] = x0[j]; }
            if (grp < 2) {
                ss = row_sum16(ss);
                const float sc = rsqrtf(ss + 1e-12f);
#pragma unroll
                for (int j = 0; j < 8; ++j) y[j] *= sc;
            }
            *(u32x4*)(GQ + (size_t)m * 1536 + ch) = pack8(y);
        }
    }
}

typedef float f32x2 __attribute__((ext_vector_type(2)));
#define LO2(v4) __builtin_shufflevector(v4, v4, 0, 1)
#define HI2(v4) __builtin_shufflevector(v4, v4, 2, 3)
#define FMA2(a, b, c) __builtin_elementwise_fma(a, b, c)
__device__ __forceinline__ float dot8(const f32x2 (&S2)[4], const f32x4 a, const f32x4 b) {
    f32x2 t = S2[0] * LO2(a); t = FMA2(S2[1], HI2(a), t); t = FMA2(S2[2], LO2(b), t); t = FMA2(S2[3], HI2(b), t); return t.x + t.y;
}
__device__ __forceinline__ float sum8(float v) {
    v += __int_as_float(__builtin_amdgcn_update_dpp(0, __float_as_int(v), 0xB1, 0xF, 0xF, true));
    v += __int_as_float(__builtin_amdgcn_update_dpp(0, __float_as_int(v), 0x4E, 0xF, 0xF, true));
    v += __int_as_float(__builtin_amdgcn_update_dpp(0, __float_as_int(v), 0x141, 0xF, 0xF, true));
    return v;
}
#define DPPADD(v, ctrl) v += __int_as_float(__builtin_amdgcn_update_dpp(0, __float_as_int(v), ctrl, 0xF, 0xF, true))
__device__ __forceinline__ void sum8x4(float& a, float& b, float& c, float& d) {
    DPPADD(a, 0xB1); DPPADD(b, 0xB1); DPPADD(c, 0xB1); DPPADD(d, 0xB1);
    DPPADD(a, 0x4E); DPPADD(b, 0x4E); DPPADD(c, 0x4E); DPPADD(d, 0x4E);
    DPPADD(a, 0x141); DPPADD(b, 0x141); DPPADD(c, 0x141); DPPADD(d, 0x141);
}
#define RWKV_LOAD(T0, W, CH) do { const size_t mw_ = (size_t)b * TSEQ + (T0) + 8 * (W); \
        if ((T0) + 8 * (W) > 0) { pr[0] = bf2f(PRKV[(mw_ - 1) * 1536 + (CH)]); pk[0] = bf2f(PRKV[(mw_ - 1) * 1536 + 512 + (CH)]); pv[0] = bf2f(PRKV[(mw_ - 1) * 1536 + 1024 + (CH)]); } \
        else { pr[0] = 0.f; pk[0] = 0.f; pv[0] = 0.f; } \
        _Pragma("unroll") for (int i = 0; i < 8; ++i) { const size_t m = mw_ + i; pr[i + 1] = bf2f(PRKV[m * 1536 + (CH)]); pk[i + 1] = bf2f(PRKV[m * 1536 + 512 + (CH)]); pv[i + 1] = bf2f(PRKV[m * 1536 + 1024 + (CH)]); \
            aa[i] = bf2f(AA[m * 512 + (CH)]); dd[i] = DEC[m * 512 + (CH)]; } } while (0)
__device__ void rwkv_scan(const Params& p, float* lds, int task) {
    const int b = task >> 3, h = task & 7, tid = otid(), w_ = tid >> 6, lane_ = tid & 63;
    constexpr int LD = 68;
    float *AT = lds, *QT = AT + 64 * LD, *BT = QT + 64 * LD, *KT = BT + 64 * LD, *G8 = KT + 64 * LD, *Vv0 = G8 + 512, *CF = Vv0 + 4096, *RED = CF + 2048, *YACC = RED + 8192, *BON0 = YACC + 4096;
    const bf16_t* PRKV = (const bf16_t*)(p.ws + OFF_PRKV); const bf16_t* AA = (const bf16_t*)(p.ws + OFF_AA); const float* DEC = (const float*)(p.ws + OFF_H);
    const bf16_t* ZRW = (const bf16_t*)(p.ws + OFF_ZRW); bf16_t* YA = (bf16_t*)(p.ws + OFF_QKV);
    f32x2 S2[4];
#pragma unroll
    for (int j = 0; j < 4; ++j) S2[j] = (f32x2){0.f, 0.f};
#pragma unroll
    for (int mq_ = 0; mq_ < 4; ++mq_) CF[(w_ * 4 + mq_) * 64 + lane_] = 0.f;
    float pr[9], pk[9], pv[9], aa[8], dd[8];
    RWKV_LOAD(0, w_, h * 64 + lane_);
    for (int blk = 0; blk < TSEQ / 64; ++blk) {
        const int t0 = blk * 64;
        float* const Vv = (blk & 1) ? RED : Vv0; float* const BON = (blk & 1) ? RED + 4096 : BON0;
        int w = w_, lane = lane_; asm volatile("" : "+v"(w), "+v"(lane));
        const int ch = h * 64 + lane;
        {
            const float mu_r = p.rw_mu[ch], mu_k = p.rw_mu[512 + ch], mu_v = p.rw_mu[1024 + ch], kkc = p.rw_k_k[ch], kac = p.rw_k_a[ch], rkc = p.rw_r_k[ch], w0c = p.rw_w0[ch], a0c = p.rw_a0[ch];
            float G = 1.f;
#pragma unroll
            for (int i = 0; i < 8; ++i) {
                const int s = 8 * w + i;
                const float r = pr[i + 1] + (pr[i] - pr[i + 1]) * mu_r, k = pk[i + 1] + (pk[i] - pk[i + 1]) * mu_k, v = pv[i + 1] + (pv[i] - pv[i + 1]) * mu_v;
                const float a = sigmoidf_(a0c + aa[i]), dec = __expf(-0.6065306597f * sigmoidf_(w0c + dd[i]));
                const float kkr = k * kkc; const float ssq = wave_sum(kkr * kkr); const float kk = kkr * rsqrtf(ssq + 1e-12f);
                const float kp = k * (1.f + (a - 1.f) * kac);
                const float bon = wave_sum(r * kp * rkc);
                const float Gp = G; G *= dec; const float iG = __builtin_amdgcn_rcpf(G);
                AT[s * LD + lane] = -kk * Gp; QT[s * LD + lane] = r * G; BT[s * LD + lane] = kk * a * iG; KT[s * LD + lane] = kp * iG; Vv[s * 64 + lane] = v;
                if (lane == 0) BON[s] = bon;
            }
            G8[w * 64 + lane] = G;
            const bool isM = lane < 36; const int idx = isM ? lane : lane - 36;
            const int tt_ = (idx >= 1) + (idx >= 3) + (idx >= 6) + (idx >= 10) + (idx >= 15) + (idx >= 21) + (idx >= 28);
            const int tq = isM ? tt_ : tt_ + 1, jq = idx - tt_ * (tt_ + 1) / 2;
            const float *rt = (isM ? QT : AT) + (8 * w + tq) * LD, *bj = BT + (8 * w + jq) * LD, *kj = KT + (8 * w + jq) * LD;
            float db = 0.f, dk = 0.f;
#pragma unroll 1
            for (int c = 0; c < 64; c += 16) {
                f32x4 a4[4], b4[4], k4[4];
#pragma unroll
                for (int i = 0; i < 4; ++i) { a4[i] = LD4(rt + c + 4 * i); b4[i] = LD4(bj + c + 4 * i); k4[i] = LD4(kj + c + 4 * i); }
                PIN();
#pragma unroll
                for (int i = 0; i < 4; ++i)
#pragma unroll
                    for (int e = 0; e < 4; ++e) { db += a4[i][e] * b4[i][e]; dk += a4[i][e] * k4[i][e]; }
            }
            CF[(w * 4 + (isM ? 2 : 0)) * 64 + tq * 8 + jq] = db; CF[(w * 4 + (isM ? 3 : 1)) * 64 + tq * 8 + jq] = dk;
        }
        __syncthreads();
        if (blk + 1 < TSEQ / 64) RWKV_LOAD(t0 + 64, w, ch);
        const int r = lane >> 3, ko = lane & 7;
        for (int mb = 0; mb < 8; ++mb) {
            float u[8], vv[8], pq[8];
            int cfo = mb * 256; asm volatile("" : "+v"(cfo));
            const float* cf = CF + cfo;
            f32x4 DA[2][8];
#define RW_LD_DOTS(buf, tp) do { const float *ap_ = AT + (mb * 8 + (tp) * 2) * LD + ko * 8, *qp_ = QT + (mb * 8 + (tp) * 2) * LD + ko * 8; \
                DA[buf][0] = LD4(ap_); DA[buf][1] = LD4(ap_ + 4); DA[buf][2] = LD4(ap_ + LD); DA[buf][3] = LD4(ap_ + LD + 4); DA[buf][4] = LD4(qp_); DA[buf][5] = LD4(qp_ + 4); DA[buf][6] = LD4(qp_ + LD); DA[buf][7] = LD4(qp_ + LD + 4); } while (0)
            RW_LD_DOTS(0, 0);
            f32x4 La[4], Ka[4];
#pragma unroll
            for (int tp = 0; tp < 4; ++tp) {
                if (tp < 3) RW_LD_DOTS((tp + 1) & 1, tp + 1);
                else {
#pragma unroll
                    for (int t = 0; t < 8; ++t) vv[t] = Vv[(mb * 8 + t) * 64 + w * 8 + r];
#pragma unroll
                    for (int t = 1; t < 4; ++t) { La[t] = LD4(cf + t * 8); Ka[t] = LD4(cf + 64 + t * 8); }
                }
                PIN();
                u[tp * 2] = dot8(S2, DA[tp & 1][0], DA[tp & 1][1]); u[tp * 2 + 1] = dot8(S2, DA[tp & 1][2], DA[tp & 1][3]);
                pq[tp * 2] = dot8(S2, DA[tp & 1][4], DA[tp & 1][5]); pq[tp * 2 + 1] = dot8(S2, DA[tp & 1][6], DA[tp & 1][7]);
                sum8x4(u[tp * 2], u[tp * 2 + 1], pq[tp * 2], pq[tp * 2 + 1]);
            }
#undef RW_LD_DOTS
            f32x4 L0[4], L1[4], K0[4], K1[4];
#pragma unroll
            for (int t = 0; t < 4; ++t) { L0[t] = LD4(cf + (4 + t) * 8); L1[t] = LD4(cf + (4 + t) * 8 + 4); K0[t] = LD4(cf + 64 + (4 + t) * 8); K1[t] = LD4(cf + 64 + (4 + t) * 8 + 4); }
            PIN();
#pragma unroll
            for (int t = 1; t < 4; ++t) { float x = u[t];
#pragma unroll
                for (int j = 0; j < 3; ++j) if (j < t) x += La[t][j] * u[j] + Ka[t][j] * vv[j];
                u[t] = x; }
            const f32x4 m0 = LD4(cf + 128 + ko * 8), m1 = LD4(cf + 128 + ko * 8 + 4), n0 = LD4(cf + 192 + ko * 8), n1 = LD4(cf + 192 + ko * 8 + 4);
            f32x4 UB[2][8];
#define RW_LD_UPD(buf, jp) do { const float *bp_ = BT + (mb * 8 + (jp) * 2) * LD + ko * 8, *kp_ = KT + (mb * 8 + (jp) * 2) * LD + ko * 8; \
                UB[buf][0] = LD4(bp_); UB[buf][1] = LD4(bp_ + 4); UB[buf][2] = LD4(bp_ + LD); UB[buf][3] = LD4(bp_ + LD + 4); UB[buf][4] = LD4(kp_); UB[buf][5] = LD4(kp_ + 4); UB[buf][6] = LD4(kp_ + LD); UB[buf][7] = LD4(kp_ + LD + 4); } while (0)
            RW_LD_UPD(0, 0);
            PIN();
#pragma unroll
            for (int t = 0; t < 4; ++t) { float x = u[4 + t];
#pragma unroll
                for (int j = 0; j < 4; ++j) { x += L0[t][j] * u[j] + K0[t][j] * vv[j]; if (j < t) x += L1[t][j] * u[4 + j] + K1[t][j] * vv[4 + j]; }
                u[4 + t] = x; }
            {
                float yc = pq[0];
#pragma unroll
                for (int t = 1; t < 8; ++t) yc = (ko == t) ? pq[t] : yc;
#pragma unroll
                for (int j = 0; j < 4; ++j) yc += m0[j] * u[j] + n0[j] * vv[j] + m1[j] * u[4 + j] + n1[j] * vv[4 + j];
                YACC[(mb * 8 + ko) * 64 + w * 8 + r] = yc;
            }
            f32x2 acc[4];
#pragma unroll
            for (int k = 0; k < 4; ++k) acc[k] = S2[k];
            f32x4 g0, g1;
#pragma unroll
            for (int jp = 0; jp < 4; ++jp) {
                if (jp < 3) RW_LD_UPD((jp + 1) & 1, jp + 1);
                else { g0 = LD4(G8 + mb * 64 + ko * 8); g1 = LD4(G8 + mb * 64 + ko * 8 + 4); }
                PIN();
                const f32x4 B0 = UB[jp & 1][0], B1 = UB[jp & 1][1], B2 = UB[jp & 1][2], B3 = UB[jp & 1][3], C0 = UB[jp & 1][4], C1 = UB[jp & 1][5], C2 = UB[jp & 1][6], C3 = UB[jp & 1][7];
                const f32x2 ua = (f32x2){u[jp * 2], u[jp * 2]}, ub = (f32x2){u[jp * 2 + 1], u[jp * 2 + 1]}, va = (f32x2){vv[jp * 2], vv[jp * 2]}, vb = (f32x2){vv[jp * 2 + 1], vv[jp * 2 + 1]};
                acc[0] = FMA2(LO2(B0), ua, acc[0]); acc[1] = FMA2(HI2(B0), ua, acc[1]); acc[2] = FMA2(LO2(B1), ua, acc[2]); acc[3] = FMA2(HI2(B1), ua, acc[3]);
                acc[0] = FMA2(LO2(C0), va, acc[0]); acc[1] = FMA2(HI2(C0), va, acc[1]); acc[2] = FMA2(LO2(C1), va, acc[2]); acc[3] = FMA2(HI2(C1), va, acc[3]);
                acc[0] = FMA2(LO2(B2), ub, acc[0]); acc[1] = FMA2(HI2(B2), ub, acc[1]); acc[2] = FMA2(LO2(B3), ub, acc[2]); acc[3] = FMA2(HI2(B3), ub, acc[3]);
                acc[0] = FMA2(LO2(C2), vb, acc[0]); acc[1] = FMA2(HI2(C2), vb, acc[1]); acc[2] = FMA2(LO2(C3), vb, acc[2]); acc[3] = FMA2(HI2(C3), vb, acc[3]);
            }
#undef RW_LD_UPD
            S2[0] = LO2(g0) * acc[0]; S2[1] = HI2(g0) * acc[1]; S2[2] = LO2(g1) * acc[2]; S2[3] = HI2(g1) * acc[3];
        }
        __syncthreads();
        asm volatile("" : "+v"(w), "+v"(lane));
        const int ch2 = h * 64 + lane;
        const float gnw = p.rw_gn_w[ch2], gnb = p.rw_gn_b[ch2];
        float zz[8];
#pragma unroll
        for (int i = 0; i < 8; ++i) zz[i] = bf2f(ZRW[((size_t)b * TSEQ + t0 + w + 8 * i) * 512 + ch2]);
#pragma unroll
        for (int i = 0; i < 8; ++i) {
            const int s = w + 8 * i; const size_t m = (size_t)b * TSEQ + t0 + s;
            const float y = YACC[s * 64 + lane];
            const float mean = wave_sum(y) * (1.f / 64.f); const float d = y - mean; const float var = wave_sum(d * d) * (1.f / 64.f);
            const float o = d * rsqrtf(var + 64e-5f) * gnw + gnb + BON[s] * Vv[s * 64 + lane];
            const float z = zz[i];
            YA[m * 512 + ch2] = f2bf(o * z * sigmoidf_(z));
        }
    }
}
#define GDN_LOAD(MB0, TID) do { \
        _Pragma("unroll") for (int i = 0; i < 2; ++i) { const int cidx = (TID) + i * 512, s = cidx >> 4, j = (cidx & 15) * 8; const size_t o = ((MB0) + s) * 1536 + h * 128 + j; \
            rq[i] = *(const u32x4*)(GQ + o); rk[i] = *(const u32x4*)(GQ + o + 512); } \
        { const int s = (TID) >> 3, c = ((TID) & 7) * 8; rv = *(const u32x4*)(GQ + ((MB0) + s) * 1536 + 1024 + h * 128 + half * 64 + c); } \
        { const float* px = PX + ((MB0) + ((TID) & 63)) * 136; pxb = px[128 + h]; pxa = px[132 + h]; } } while (0)
__device__ void gdn_scan(const Params& p, float* lds, int task) {
    const int half = task & 1, h = (task >> 1) & 3, b = task >> 3, tid_ = otid();
    constexpr int LD = 132;
    float *Q = lds, *K = Q + 64 * LD, *V = K + 64 * LD, *CF = V + 4096, *RED = CF + 1024, *OACC = RED + 8192, *LG = OACC + 4096, *BE = LG + 64, *EG = BE + 64, *ER = EG + 64;
    const bf16_t* GQ = (const bf16_t*)(p.ws + OFF_GQKV); const float* PX = (const float*)(p.ws + OFF_PX);
    float* OB = (float*)(p.ws + OFF_QKV + 33554432ull);
    const float nA = -__expf(p.gd_A_log[h]), dtb = p.gd_dt_bias[h];
    f32x2 S2[8];
#pragma unroll
    for (int j = 0; j < 8; ++j) S2[j] = (f32x2){0.f, 0.f};
    { const int w0_ = tid_ >> 6, l0_ = tid_ & 63; CF[(w0_ * 2) * 64 + l0_] = 0.f; CF[(w0_ * 2 + 1) * 64 + l0_] = 0.f; }
    u32x4 rq[2], rk[2], rv; float pxb, pxa;
    GDN_LOAD((size_t)b * TSEQ, tid_);
    for (int blk = 0; blk < TSEQ / 64; ++blk) {
        const size_t mb0 = (size_t)b * TSEQ + blk * 64;
        int tid = tid_; asm volatile("" : "+v"(tid));
        const int w = tid >> 6, lane = tid & 63;
        {
#pragma unroll
            for (int i = 0; i < 2; ++i) { const int cidx = tid + i * 512, s = cidx >> 4, j = (cidx & 15) * 8; float f[8];
                unpack8(rq[i], f);
                *(f32x4*)(Q + s * LD + j) = (f32x4){f[0], f[1], f[2], f[3]} * 0.08838834764831845f; *(f32x4*)(Q + s * LD + j + 4) = (f32x4){f[4], f[5], f[6], f[7]} * 0.08838834764831845f;
                unpack8(rk[i], f);
                *(f32x4*)(K + s * LD + j) = (f32x4){f[0], f[1], f[2], f[3]}; *(f32x4*)(K + s * LD + j + 4) = (f32x4){f[4], f[5], f[6], f[7]}; }
            { const int s = tid >> 3, c = (tid & 7) * 8; float f[8]; unpack8(rv, f);
                *(f32x4*)(V + s * 64 + c) = (f32x4){f[0], f[1], f[2], f[3]}; *(f32x4*)(V + s * 64 + c + 4) = (f32x4){f[4], f[5], f[6], f[7]}; }
        }
        if (tid < 64) {
            BE[tid] = sigmoidf_(pxb);
            float c = nA * softplusf_(pxa + dtb);
#pragma unroll
            for (int off = 1; off < 4; off <<= 1) { const float n = __shfl_up(c, off); if ((tid & 3) >= off) c += n; }
            LG[tid] = c; EG[tid] = __expf(c);
            const float cend = __shfl(c, tid | 3); ER[tid] = __expf(cend - c);
        }
        __syncthreads();
        {
            const int hf = lane & 1, pidx = lane >> 1, gq = pidx >> 4, q = pidx & 15;
            const bool isM = q < 10; const int rr = isM ? q : q - 10;
            const int tt_ = isM ? ((rr >= 1) + (rr >= 3) + (rr >= 6)) : ((rr >= 1) + (rr >= 3));
            const int t4 = isM ? tt_ : tt_ + 1, j4 = rr - tt_ * (tt_ + 1) / 2;
            const int st = 8 * w + 4 * gq + t4, sj = 8 * w + 4 * gq + j4;
            const float *ra = (isM ? Q : K) + st * LD + hf * 64, *rb = K + sj * LD + hf * 64;
            float dsum = 0.f;
#pragma unroll
            for (int c = 0; c < 64; c += 32) {
                f32x4 a4[8], b4[8];
#pragma unroll
                for (int i = 0; i < 8; ++i) { a4[i] = LD4(ra + c + 4 * i); b4[i] = LD4(rb + c + 4 * i); }
                PIN();
#pragma unroll
                for (int i = 0; i < 8; ++i)
#pragma unroll
                    for (int e = 0; e < 4; ++e) dsum += a4[i][e] * b4[i][e];
            }
            DPPADD(dsum, 0xB1);
            const float ratio = __expf(fminf(LG[st] - LG[sj], 0.f));
            const float val = isM ? ratio * dsum : BE[st] * ratio * dsum;
            if (hf == 0) CF[(w * 2 + (isM ? 1 : 0)) * 64 + (4 * gq + t4) * 8 + 4 * gq + j4] = val;
        }
        __syncthreads();
        if (blk + 1 < TSEQ / 64) GDN_LOAD(mb0 + 64, tid);
        const int r = lane >> 3, ko = lane & 7;
        for (int g = 0; g < 16; ++g) {
            const int s0 = g * 4, hb = (g & 1) * 4;
            const float *kp = K + s0 * LD + ko * 16, *qp = Q + s0 * LD + ko * 16;
            f32x4 KK[4][4];
            float d[4], c[4], pe[4];
#pragma unroll
            for (int tp = 0; tp < 2; ++tp) {
                f32x4 QQ[2][4];
#pragma unroll
                for (int t = 0; t < 2; ++t)
#pragma unroll
                    for (int j = 0; j < 4; ++j) { KK[tp * 2 + t][j] = LD4(kp + (tp * 2 + t) * LD + j * 4); QQ[t][j] = LD4(qp + (tp * 2 + t) * LD + j * 4); }
                PIN();
                f32x2 x0 = S2[0] * LO2(KK[tp * 2][0]), y0 = S2[0] * LO2(QQ[0][0]), x1 = S2[0] * LO2(KK[tp * 2 + 1][0]), y1 = S2[0] * LO2(QQ[1][0]);
                x0 = FMA2(S2[1], HI2(KK[tp * 2][0]), x0); y0 = FMA2(S2[1], HI2(QQ[0][0]), y0); x1 = FMA2(S2[1], HI2(KK[tp * 2 + 1][0]), x1); y1 = FMA2(S2[1], HI2(QQ[1][0]), y1);
#pragma unroll
                for (int j = 1; j < 4; ++j) {
                    x0 = FMA2(S2[2 * j], LO2(KK[tp * 2][j]), x0); y0 = FMA2(S2[2 * j], LO2(QQ[0][j]), y0); x1 = FMA2(S2[2 * j], LO2(KK[tp * 2 + 1][j]), x1); y1 = FMA2(S2[2 * j], LO2(QQ[1][j]), y1);
                    x0 = FMA2(S2[2 * j + 1], HI2(KK[tp * 2][j]), x0); y0 = FMA2(S2[2 * j + 1], HI2(QQ[0][j]), y0); x1 = FMA2(S2[2 * j + 1], HI2(KK[tp * 2 + 1][j]), x1); y1 = FMA2(S2[2 * j + 1], HI2(QQ[1][j]), y1);
                }
                d[tp * 2] = x0.x + x0.y; d[tp * 2 + 1] = x1.x + x1.y; pe[tp * 2] = y0.x + y0.y; pe[tp * 2 + 1] = y1.x + y1.y;
                sum8x4(d[tp * 2], d[tp * 2 + 1], pe[tp * 2], pe[tp * 2 + 1]);
            }
            float eg[4], er[4], be[4];
#pragma unroll
            for (int t = 0; t < 4; ++t) { c[t] = V[(s0 + t) * 64 + w * 8 + r]; eg[t] = EG[s0 + t]; er[t] = ER[s0 + t]; be[t] = BE[s0 + t]; }
            int cfo = (g >> 1) * 128; asm volatile("" : "+v"(cfo));
            const float* cf = CF + cfo;
            {
                f32x4 L[4];
#pragma unroll
                for (int t = 1; t < 4; ++t) L[t] = LD4(cf + (hb + t) * 8 + hb);
                const f32x4 mq = LD4(cf + 64 + (hb + (ko & 3)) * 8 + hb);
                PIN();
#pragma unroll
                for (int t = 0; t < 4; ++t) {
                    float x = be[t] * (c[t] - eg[t] * d[t]);
#pragma unroll
                    for (int j = 0; j < 3; ++j) if (j < t) x -= L[t < 1 ? 1 : t][j] * c[j];
                    c[t] = x;
                }
                float oc = eg[0] * pe[0];
#pragma unroll
                for (int t = 1; t < 4; ++t) oc = ((ko & 3) == t) ? eg[t] * pe[t] : oc;
#pragma unroll
                for (int j = 0; j < 4; ++j) oc += mq[j] * c[j];
                if (ko < 4) OACC[(s0 + ko) * 64 + w * 8 + r] = oc;
            }
            const f32x2 g4 = (f32x2){eg[3], eg[3]};
#pragma unroll
            for (int k = 0; k < 8; ++k) S2[k] *= g4;
#pragma unroll
            for (int t = 0; t < 4; ++t) {
                const float cs = er[t] * c[t]; const f32x2 c2 = (f32x2){cs, cs};
#pragma unroll
                for (int q = 0; q < 4; ++q) { S2[2 * q] = FMA2(LO2(KK[t][q]), c2, S2[2 * q]); S2[2 * q + 1] = FMA2(HI2(KK[t][q]), c2, S2[2 * q + 1]); }
            }
        }
        __syncthreads();
        for (int idx = tid; idx < 4096; idx += 512) { const int s = idx >> 6, c = idx & 63; OB[(mb0 + s) * 512 + h * 128 + half * 64 + c] = OACC[idx]; }
    }
}
__device__ void phase35(const Params& p) {
    const int tid = otid(), lane = tid & 63, gw = blockIdx.x * 8 + (tid >> 6), nw = gridDim.x * 8;
    const float* OB = (const float*)(p.ws + OFF_QKV + 33554432ull); const bf16_t* ZGD = (const bf16_t*)(p.ws + OFF_ZGD); bf16_t* YB = (bf16_t*)(p.ws + OFF_AA);
    float onw[8];
#pragma unroll
    for (int j = 0; j < 8; ++j) onw[j] = p.gd_o_norm_w[(lane * 8 + j) & 127];
    for (int m0 = gw; m0 < MTOK; m0 += 4 * nw) {
        f32x4 a[4], bq[4]; u32x4 zr[4];
#pragma unroll
        for (int q = 0; q < 4; ++q) { const int m = min(m0 + q * nw, MTOK - 1); a[q] = *(const f32x4*)(OB + (size_t)m * 512 + lane * 8); bq[q] = *(const f32x4*)(OB + (size_t)m * 512 + lane * 8 + 4); zr[q] = *(const u32x4*)(ZGD + (size_t)m * 512 + lane * 8); }
        PIN();
#pragma unroll
        for (int q = 0; q < 4; ++q) {
            const int m = m0 + q * nw; if (m >= MTOK) break;
            float o[8] = {a[q][0], a[q][1], a[q][2], a[q][3], bq[q][0], bq[q][1], bq[q][2], bq[q][3]}, z[8];
            unpack8(zr[q], z);
            float ss = 0.f;
#pragma unroll
            for (int j = 0; j < 8; ++j) ss += o[j] * o[j];
            ss = row_sum16(ss);
            const float rs = rsqrtf(ss * (1.f / 128.f) + 1e-6f);
#pragma unroll
            for (int j = 0; j < 8; ++j) o[j] = o[j] * rs * onw[j] * z[j] * sigmoidf_(z[j]);
            *(u32x4*)(YB + (size_t)m * 512 + lane * 8) = pack8(o);
        }
    }
}
__device__ void phase6(const Params& p) {
    const float* rss = (const float*)(p.ws + OFF_RSS);
    const size_t stride = (size_t)gridDim.x * 512, total = (size_t)MTOK * 256;
    for (size_t i0 = (size_t)blockIdx.x * 512 + otid(); i0 < total; i0 += 4 * stride) {
        f32x4 v[4]; float sq[4];
#pragma unroll
        for (int q = 0; q < 4; ++q) { const size_t i = i0 + q * stride < total ? i0 + q * stride : i0; v[q] = *(const f32x4*)(p.out + i * 4); sq[q] = rss[i >> 8]; }
        PIN();
#pragma unroll
        for (int q = 0; q < 4; ++q) {
            const size_t i = i0 + q * stride; if (i >= total) break;
            const float rs = rsqrtf(sq[q] * (1.f / 1024.f) + 1e-6f); const f32x4 g = *(const f32x4*)(p.norm_out_w + (int)(i & 255) * 4);
            f32x4 o = v[q]; o[0] *= rs * g[0]; o[1] *= rs * g[1]; o[2] *= rs * g[2]; o[3] *= rs * g[3];
            *(f32x4*)(p.out + i * 4) = o;
        }
    }
}

#define XB_TMO      128
#define XB_XCNT(j)  (256  + 64 * (j))
#define XB_XSUB(j)  (1280 + 64 * (j))
#define XB_XGEN(j)  (2304 + 64 * (j))
#define XB_TOP      3328
#define XB_TOPGEN   3392
#define XCD_BAR_WORDS 3456
#define XB_SPIN_CAP (1u << 18)

__device__ __forceinline__ unsigned xb_ld(unsigned* p)              { return __hip_atomic_load(p, __ATOMIC_RELAXED, __HIP_MEMORY_SCOPE_AGENT); }
__device__ __forceinline__ unsigned xb_add(unsigned* p, unsigned v) { return __hip_atomic_fetch_add(p, v, __ATOMIC_RELAXED, __HIP_MEMORY_SCOPE_AGENT); }
__device__ __forceinline__ unsigned xb_xcc_id() { return (unsigned)__builtin_amdgcn_s_getreg((3 << 11) | 20) & 0xFu; }
#define XB_SPIN(cond, bar) do { unsigned _sp = 0; while (cond) { __builtin_amdgcn_s_sleep(1); \
    if ((++_sp & 255u) == 0u) { if (xb_ld(&(bar)[XB_TMO])) break; if (_sp > XB_SPIN_CAP) { atomicAdd(&(bar)[XB_TMO], 1u); break; } } } } while (0)

struct XcdBarrier {
    unsigned* bar; unsigned x;
    volatile LAS unsigned* st;
};

__device__ __forceinline__ XcdBarrier xcd_barrier_post(unsigned* bar, volatile LAS unsigned* st) {
    XcdBarrier b; b.bar = bar; b.x = xb_xcc_id(); b.st = st;
    if (threadIdx.x == 0) (void)xb_add(&bar[XB_XCNT(b.x)], 1u);
    return b;
}
__device__ __forceinline__ void xcd_barrier_complete(unsigned* bar, unsigned x, unsigned& nloc, unsigned& nx) {
    const unsigned G = gridDim.x * gridDim.y * gridDim.z;
    unsigned sum, cnt, mine, sp = 0u;
    for (;;) {
        sum = 0u; cnt = 0u; mine = 0u;
#pragma unroll
        for (unsigned j = 0; j < 16; ++j) { const unsigned c = xb_ld(&bar[XB_XCNT(j)]); sum += c; cnt += (c > 0u) ? 1u : 0u; mine = (j == x) ? c : mine; }
        if (sum == G) break;
        __builtin_amdgcn_s_sleep(1);
        if ((++sp & 255u) == 0u) { if (xb_ld(&bar[XB_TMO])) break; if (sp > XB_SPIN_CAP) { atomicAdd(&bar[XB_TMO], 1u); break; } }
    }
    nloc = mine > 0u ? mine : 1u; nx = cnt > 0u ? cnt : 1u;
}

__device__ __forceinline__ void xcd_barrier(const XcdBarrier& b) {
    asm volatile("s_waitcnt vmcnt(0)" ::: "memory");
    __syncthreads();
    if (threadIdx.x == 0) {
        unsigned* bar = b.bar;
        __builtin_amdgcn_s_waitcnt(0);
        unsigned nloc = b.st[0], nx = b.st[1];
        if (nloc == 0u) { xcd_barrier_complete(bar, b.x, nloc, nx); b.st[0] = nloc; b.st[1] = nx; }
        const unsigned old = xb_add(&bar[XB_XSUB(b.x)], 1u);
        const unsigned gen = old / nloc;
        if (old + 1u == (gen + 1u) * nloc) {
            __builtin_amdgcn_fence(__ATOMIC_RELEASE, "agent");
            asm volatile("s_waitcnt vmcnt(0)" ::: "memory");
            const unsigned og = xb_add(&bar[XB_TOP], 1u);
            const unsigned tg = og / nx;
            if (og + 1u == (tg + 1u) * nx) xb_add(&bar[XB_TOPGEN], 1u);
            else XB_SPIN(xb_ld(&bar[XB_TOPGEN]) == tg, bar);
            __builtin_amdgcn_fence(__ATOMIC_ACQUIRE, "agent");
            xb_add(&bar[XB_XGEN(b.x)], 1u);
            asm volatile("s_waitcnt vmcnt(0)" ::: "memory");
        } else {
            XB_SPIN(xb_ld(&bar[XB_XGEN(b.x)]) == gen, bar);
            __builtin_amdgcn_fence(__ATOMIC_ACQUIRE, "agent");
            asm volatile("s_waitcnt vmcnt(0)" ::: "memory");
        }
    }
    __syncthreads();
}


constexpr int NPHASE = 10;
template <int PH> __device__ __forceinline__ void run_phase(const Params& p, unsigned char* shm) {
    float* ldsf = (float*)shm;
    LAS unsigned char* lds3 = (LAS unsigned char*)shm;
    pg8::StaticOrder S;
    if constexpr (PH == 0) phase0(p, ldsf);
    if constexpr (PH == 1) { pg8::Gemm g{(const bf16_t*)(p.ws + OFF_H), (const bf16_t*)(p.ws + OFF_BTIN), MTOK, NPAD, 1024}; S.init(g.M, g.N, (int)gridDim.x, (int)blockIdx.x);
                  EpiIn E{p.ws, p.out}; pg8::gemm_phase(lds3, g, S, E); }
    if constexpr (PH == 2) phase2(p);
    if constexpr (PH == 3) { pg8::Gemm g{(const bf16_t*)(p.ws + OFF_AP), (const bf16_t*)(p.ws + OFF_BTS), MTOK, 1024, 256}; S.init(g.M, g.N, (int)gridDim.x, (int)blockIdx.x);
                  EpiSmall E{p.ws}; pg8::gemm_phase(lds3, g, S, E); }
    if constexpr (PH == 4) { for (int t = blockIdx.x; t < 256; t += gridDim.x) { if (t < 128) rwkv_scan(p, ldsf, t); else gdn_scan(p, ldsf, t - 128); } }
    if constexpr (PH == 5) phase35(p);
    if constexpr (PH == 6) { pg8::Gemm g{(const bf16_t*)(p.ws + OFF_QKV), (const bf16_t*)(p.ws + OFF_BTA), MTOK, 1024, 1024, (const bf16_t*)(p.ws + OFF_AA), 512, 8}; S.init(g.M, g.N, (int)gridDim.x, (int)blockIdx.x);
                  EpiAB E{p.ws, p.out}; pg8::gemm_phase(lds3, g, S, E); }
    if constexpr (PH == 8) { pg8::Gemm g{(const bf16_t*)(p.ws + OFF_GQKV), (const bf16_t*)(p.ws + OFF_BTO), MTOK, 1024, 1024}; S.init(g.M, g.N, (int)gridDim.x, (int)blockIdx.x);
                  EpiC3 E{p.x, p.out, (float*)(p.ws + OFF_RSS)}; pg8::gemm_phase(lds3, g, S, E); }
    if constexpr (PH == 9) phase6(p);
}
template <int PH> __global__ __launch_bounds__(512) void fwd_phase(Params p) {
    extern __shared__ __attribute__((aligned(16))) unsigned char shm[];
    run_phase<PH>(p, shm);
}
#ifndef N_LAUNCH_MODE
#define N_LAUNCH_MODE 1
#endif
#ifndef REPEAT_MASK
#define REPEAT_MASK 0
#endif
#ifndef MEGA_MASK
#define MEGA_MASK 1023
#endif
#if N_LAUNCH_MODE == 1
__global__ __launch_bounds__(512) void fwd_mega(Params p) {
    extern __shared__ __attribute__((aligned(16))) unsigned char shm[];
    cg::grid_group grid = cg::this_grid();
    if (threadIdx.x < 4) ((unsigned*)(shm + LDS_BYTES - 16))[threadIdx.x] = 0u;
    __syncthreads();
    XcdBarrier xb = xcd_barrier_post((unsigned*)(p.ws + OFF_BAR), (volatile LAS unsigned*)(shm + LDS_BYTES - 16));
#if (MEGA_MASK >> 0) & 1
    run_phase<0>(p, shm);
#endif
#if (REPEAT_MASK >> 0) & 1
    xcd_barrier(xb); run_phase<0>(p, shm);
#endif
    xcd_barrier(xb);
#if (MEGA_MASK >> 1) & 1
    run_phase<1>(p, shm);
#endif
#if (REPEAT_MASK >> 1) & 1
    xcd_barrier(xb); run_phase<1>(p, shm);
#endif
    xcd_barrier(xb);
#if (MEGA_MASK >> 2) & 1
    run_phase<2>(p, shm);
#endif
#if (REPEAT_MASK >> 2) & 1
    xcd_barrier(xb); run_phase<2>(p, shm);
#endif
    xcd_barrier(xb);
#if (MEGA_MASK >> 3) & 1
    run_phase<3>(p, shm);
#endif
#if (REPEAT_MASK >> 3) & 1
    xcd_barrier(xb); run_phase<3>(p, shm);
#endif
    xcd_barrier(xb);
#if (MEGA_MASK >> 4) & 1
    run_phase<4>(p, shm);
#endif
#if (REPEAT_MASK >> 4) & 1
    xcd_barrier(xb); run_phase<4>(p, shm);
#endif
    grid.sync();
#if (MEGA_MASK >> 5) & 1
    run_phase<5>(p, shm);
#endif
#if (REPEAT_MASK >> 5) & 1
    xcd_barrier(xb); run_phase<5>(p, shm);
#endif
    xcd_barrier(xb);
#if (MEGA_MASK >> 6) & 1
    run_phase<6>(p, shm);
#endif
#if (REPEAT_MASK >> 6) & 1
    xcd_barrier(xb); run_phase<6>(p, shm);
#endif
    xcd_barrier(xb);
#if (MEGA_MASK >> 8) & 1
    run_phase<8>(p, shm);
#endif
#if (REPEAT_MASK >> 8) & 1
    xcd_barrier(xb); run_phase<8>(p, shm);
#endif
    xcd_barrier(xb);
#if (MEGA_MASK >> 9) & 1
    run_phase<9>(p, shm);
#endif
#if (REPEAT_MASK >> 9) & 1
    xcd_barrier(xb); run_phase<9>(p, shm);
#endif
}
#endif

#ifndef N_LAUNCH_MODE
#define N_LAUNCH_MODE 1
#endif
template <int... I> static void set_attrs(std::integer_sequence<int, I...>) { ((void)hipFuncSetAttribute((const void*)fwd_phase<I>, hipFuncAttributeMaxDynamicSharedMemorySize, LDS_BYTES), ...); }
template <int... I> static void launch_all(std::integer_sequence<int, I...>, const Params& p, int grid, hipStream_t stream) { ((fwd_phase<I><<<dim3(grid), dim3(512), LDS_BYTES, stream>>>(p)), ...); }
extern "C" void kernel_launch(void* const* d_in, const int* in_sizes, int n_in, void* d_out, int out_size, void* d_ws, size_t ws_size, hipStream_t stream) {
    static int grid = 0;
    if (grid == 0) {
        if (n_in != 21 || ws_size < WS_END) { fprintf(stderr, "kernel_launch: unexpected n_in %d / ws %zu (need %zu)\n", n_in, ws_size, (size_t)WS_END); grid = -1; return; }
        int dev = 0, cus = 0, per_cu = 0;
        (void)hipGetDevice(&dev); (void)hipDeviceGetAttribute(&cus, hipDeviceAttributeMultiprocessorCount, dev);
#if N_LAUNCH_MODE == 1
        (void)hipFuncSetAttribute((const void*)fwd_mega, hipFuncAttributeMaxDynamicSharedMemorySize, LDS_BYTES);
        (void)hipOccupancyMaxActiveBlocksPerMultiprocessor(&per_cu, (const void*)fwd_mega, 512, LDS_BYTES);
#else
        set_attrs(std::make_integer_sequence<int, NPHASE>{});
        per_cu = 1;
#endif
        if (per_cu < 1) per_cu = 1;
        grid = cus * per_cu;
        (void)hipGetLastError();
    }
    if (grid < 0) return;
    Params p{};
    const float** dst = (const float**)&p;
    for (int i = 0; i < 21; ++i) dst[i] = (const float*)d_in[i];
    p.out = (float*)d_out; p.ws = (unsigned char*)d_ws;
#if N_LAUNCH_MODE == 1
    (void)hipMemsetAsync((char*)d_ws + OFF_BAR, 0, 16384, stream);
    void* args[] = {&p};
    hipError_t e = hipLaunchCooperativeKernel((const void*)fwd_mega, dim3(grid), dim3(512), args, LDS_BYTES, stream);
    if (e != hipSuccess) fprintf(stderr, "cooperative launch failed: %s (grid %d)\n", hipGetErrorString(e), grid);
#else
    launch_all(std::make_integer_sequence<int, NPHASE>{}, p, grid, stream);
#endif
}
```

```cpp
#include <hip/hip_runtime.h>
#include <hip/hip_cooperative_groups.h>
#include <cstdio>
#include <utility>
namespace cg = cooperative_groups;
namespace pg8 {
#define PG8_LAS __attribute__((address_space(3)))
typedef unsigned short bf16_t;
typedef short bf16x8 __attribute__((ext_vector_type(8)));
typedef float f32x4 __attribute__((ext_vector_type(4)));
typedef unsigned u32x4 __attribute__((ext_vector_type(4)));
constexpr int BM = 256, BK = 64, HALF = 128, HTB = HALF * BK * 2  , STAGE_BYTES = 8 * HTB, NXCD = 8, WGM = 8;

__host__ __device__ __forceinline__ int lds_byte(int r, int c) { const int st = (r >> 4) * 2 + (c >> 5), rr = r & 15, cc = c & 31, ob = rr * 64 + cc * 2; return st * 1024 + (ob ^ (((ob >> 9) & 1) << 5)); }
__host__ __device__ __forceinline__ void stage_rc(int b, int& R, int& C) { const int st = b / 1024, sb = b % 1024, swz = sb ^ (((sb >> 9) & 1) << 5); R = (st >> 1) * 16 + swz / 64; C = (st & 1) * 32 + (swz % 64) / 2; }
__host__ __device__ __forceinline__ int perm32(int rho) { const int n = rho >> 4, i = rho & 15; return 8 * (i >> 2) + 4 * n + (i & 3); }


struct Unit { int pm, pn; };
struct Gemm { const bf16_t* A; const bf16_t* Bt; int M, N, K; const bf16_t* A2; int lda, ksplit; };
struct StaticOrder {
    int nM, nN, nwg, G, c;
    __host__ __device__ void init(int M, int N, int G_, int c_) { nM = M / BM; nN = N / BM; nwg = nM * nN; G = G_; c = c_; }
    __host__ __device__ bool next(int i, Unit& u) const {
        const long L = (long)i * G + c; if (L >= nwg) return false;
        int wgid = (int)L; { const int q = nwg / NXCD, r = nwg % NXCD, xcd = wgid % NXCD, off = wgid / NXCD; wgid = (xcd < r ? xcd * (q + 1) : r * (q + 1) + (xcd - r) * q) + off; }
        const int nig = WGM * nN, gid = wgid / nig, fm = gid * WGM, gsz = (nM - fm) < WGM ? (nM - fm) : WGM;
        u.pm = fm + ((wgid % nig) % gsz); u.pn = (wgid % nig) / gsz; return true;
    }
    __device__ __forceinline__ void a_ready(const Unit&) const {}
    __device__ __forceinline__ void done(const Unit&) const {}
};
__device__ __forceinline__ unsigned cvt_pk_bf16(float lo, float hi) { unsigned r; asm volatile("v_cvt_pk_bf16_f32 %0, %1, %2" : "=v"(r) : "v"(lo), "v"(hi)); return r; }
template <class Epi, class Sched>
__device__ __forceinline__ void gemm_phase(PG8_LAS unsigned char* lds, const Gemm g, const Sched& S, const Epi& E) {
    int tid_ = threadIdx.x; asm volatile("" : "+v"(tid_));
    const int tid = tid_, wid = __builtin_amdgcn_readfirstlane(tid >> 6), lane = tid & 63, wr = wid >> 2, wc = wid & 3, fr = lane & 15, fq = lane >> 4;
    int K_ = g.K; asm volatile("" : "+s"(K_));
    const int K = K_, nt = K / BK;
    const int lda = Epi::SPLIT_A ? g.lda : K, ksplit = Epi::SPLIT_A ? g.ksplit : 0;
    unsigned voffA[2], voffB[2];
#pragma unroll
    for (int i = 0; i < 2; ++i) { int R, C; stage_rc(tid * 16 + i * 8192, R, C); const int Rb = Epi::PERM ? ((R & ~31) + perm32(R & 31)) : R;
        voffA[i] = (unsigned)(R * lda + C) * 2u; voffB[i] = (unsigned)(Rb * K + C) * 2u; }
    const size_t kstep = (size_t)(BK * 2);
    const size_t hstep = (size_t)HALF * K * 2;
    const size_t tstep = 2 * hstep;
    const size_t hstepA = (size_t)HALF * lda * 2, tstepA = 2 * hstepA;
    const unsigned ldsw = (unsigned)wid * 1024u;
    const int aoff = lds_byte(wr * 64 + fr, fq * 8), boff = lds_byte(wc * 32 + fr, fq * 8);
#define PG8_SA(b, h) (((b) * 2 + (h)) * HTB)
#define PG8_SB(b, h) ((4 + (b) * 2 + (h)) * HTB)
#define PG8_STAGE(bufoff, gbase, voff) do { _Pragma("unroll") for (int _i = 0; _i < 2; ++_i) \
        __builtin_amdgcn_global_load_lds((const unsigned*)((const char*)(gbase) + (voff)[_i]), (PG8_LAS unsigned*)(lds + (bufoff) + ldsw + _i * 8192), 16, 0, 0); } while (0)
#define PG8_LDA(dst, b, h) do { _Pragma("unroll") for (int m = 0; m < 4; ++m) _Pragma("unroll") for (int k = 0; k < 2; ++k) dst[m][k] = *(const PG8_LAS bf16x8*)(lds + PG8_SA(b, h) + aoff + m * 2048 + k * 1024); } while (0)
#define PG8_LDB(dst, b, h) do { _Pragma("unroll") for (int n = 0; n < 2; ++n) _Pragma("unroll") for (int k = 0; k < 2; ++k) dst[n][k] = *(const PG8_LAS bf16x8*)(lds + PG8_SB(b, h) + boff + n * 2048 + k * 1024); } while (0)
#define PG8_MMA(ai, bj, At, Bt) do { __builtin_amdgcn_s_setprio(1); _Pragma("unroll") for (int m = 0; m < 4; ++m) _Pragma("unroll") for (int n = 0; n < 2; ++n) _Pragma("unroll") for (int k = 0; k < 2; ++k) \
        acc[ai][bj][m][n] = __builtin_amdgcn_mfma_f32_16x16x32_bf16(Bt[n][k], At[m][k], acc[ai][bj][m][n], 0, 0, 0); __builtin_amdgcn_s_setprio(0); } while (0)
#define PG8_WAIT_V(n) asm volatile("s_waitcnt vmcnt(" #n ")" ::: "memory")
#define PG8_WAIT_L(n) asm volatile("s_waitcnt lgkmcnt(" #n ")" ::: "memory")
#define PG8_BAR __builtin_amdgcn_s_barrier()
#define PG8_SCHED __builtin_amdgcn_sched_barrier(0)
    Unit cur, nxt; int ui = 0;
    if (!S.next(0, cur)) return;
    f32x4 acc[2][2][4][2];
#pragma unroll
    for (int a = 0; a < 2; ++a)
#pragma unroll
        for (int b = 0; b < 2; ++b)
#pragma unroll
            for (int m = 0; m < 4; ++m)
#pragma unroll
                for (int n = 0; n < 2; ++n) acc[a][b][m][n] = (f32x4){0.f, 0.f, 0.f, 0.f};
    bf16x8 At[4][2], B0[2][2], B1[2][2];
    const char* cA = (const char*)g.A + (size_t)cur.pm * tstepA; const char* cB = (const char*)g.Bt + (size_t)cur.pn * tstep;
    const char* cA2 = Epi::SPLIT_A ? (const char*)g.A2 + (size_t)cur.pm * tstepA : cA;
    S.a_ready(cur);
    PG8_STAGE(PG8_SB(0, 0), cB, voffB); PG8_STAGE(PG8_SA(0, 0), cA, voffA); PG8_STAGE(PG8_SB(0, 1), cB + hstep, voffB); PG8_STAGE(PG8_SA(0, 1), cA + hstepA, voffA);
    if (wr == 1) PG8_BAR;
    PG8_WAIT_V(4); PG8_BAR;
    PG8_STAGE(PG8_SB(1, 0), cB + kstep, voffB); PG8_STAGE(PG8_SA(1, 0), cA + kstep, voffA); PG8_STAGE(PG8_SB(1, 1), cB + hstep + kstep, voffB);
    PG8_WAIT_V(6); PG8_BAR;
    for (;;) {
        const bool has_next = S.next(ui + 1, nxt);
        const char* nA = has_next ? (const char*)g.A + (size_t)nxt.pm * tstepA : cA; const char* nB = has_next ? (const char*)g.Bt + (size_t)nxt.pn * tstep : cB;
        const char* nA2 = (Epi::SPLIT_A && has_next) ? (const char*)g.A2 + (size_t)nxt.pm * tstepA : cA2;
        for (int t = 0; t < nt; t += 2) {
            const bool last = (t == nt - 2);
            const char* a1 = (Epi::SPLIT_A && t + 1 >= ksplit) ? cA2 + (size_t)(t + 1 - ksplit) * kstep : cA + (size_t)(t + 1) * kstep;
            const char* a2 = last ? nA : ((Epi::SPLIT_A && t + 2 >= ksplit) ? cA2 + (size_t)(t + 2 - ksplit) * kstep : cA + (size_t)(t + 2) * kstep); const char* b2 = last ? nB : cB + (size_t)(t + 2) * kstep;
            const char* a3 = a2 + kstep; const char* b3 = b2 + kstep;
            if (last && has_next) S.a_ready(nxt);
            if constexpr (Epi::SPLIT_A) { if (t == ksplit) E.mid(acc, cur, wr, wc, fr, fq); }
            PG8_LDB(B0, 0, 0); PG8_SCHED; PG8_LDA(At, 0, 0); PG8_STAGE(PG8_SA(1, 1), a1 + hstepA, voffA);
            PG8_WAIT_L(8); PG8_BAR; PG8_WAIT_L(0); PG8_MMA(0, 0, At, B0); PG8_BAR; PG8_SCHED;
            PG8_LDB(B1, 0, 1); PG8_STAGE(PG8_SB(0, 0), b2, voffB);
            PG8_BAR; PG8_WAIT_L(0); PG8_MMA(0, 1, At, B1); PG8_BAR;
            PG8_LDA(At, 0, 1); PG8_STAGE(PG8_SA(0, 0), a2, voffA);
            PG8_BAR; PG8_WAIT_L(0); PG8_MMA(1, 0, At, B0); PG8_BAR; PG8_SCHED;
            PG8_STAGE(PG8_SB(0, 1), b2 + hstep, voffB);
            PG8_WAIT_V(6); PG8_BAR; PG8_MMA(1, 1, At, B1); PG8_BAR;
            PG8_LDB(B0, 1, 0); PG8_SCHED; PG8_LDA(At, 1, 0); PG8_STAGE(PG8_SA(0, 1), a2 + hstepA, voffA);
            PG8_WAIT_L(8); PG8_BAR; PG8_WAIT_L(0); PG8_MMA(0, 0, At, B0); PG8_BAR; PG8_SCHED;
            PG8_LDB(B1, 1, 1); PG8_STAGE(PG8_SB(1, 0), b3, voffB);
            PG8_BAR; PG8_WAIT_L(0); PG8_MMA(0, 1, At, B1); PG8_BAR;
            PG8_LDA(At, 1, 1); PG8_STAGE(PG8_SA(1, 0), a3, voffA);
            PG8_BAR; PG8_WAIT_L(0); PG8_MMA(1, 0, At, B0); PG8_BAR; PG8_SCHED;
            PG8_STAGE(PG8_SB(1, 1), b3 + hstep, voffB);
            PG8_WAIT_V(6); PG8_BAR; PG8_MMA(1, 1, At, B1); PG8_BAR;
        }
        if constexpr (!Epi::AFTER_DRAIN) { E(acc, cur, wr, wc, fr, fq); S.done(cur); }
        if (!has_next) break;
#pragma unroll
        for (int a = 0; a < 2; ++a)
#pragma unroll
            for (int b = 0; b < 2; ++b)
#pragma unroll
                for (int m = 0; m < 4; ++m)
#pragma unroll
                    for (int n = 0; n < 2; ++n) acc[a][b][m][n] = (f32x4){0.f, 0.f, 0.f, 0.f};
        cur = nxt; cA = nA; cA2 = nA2; cB = nB; ++ui;
    }
    PG8_WAIT_V(0);
    if (wr == 0) PG8_BAR;
    PG8_BAR;
    if constexpr (Epi::AFTER_DRAIN) { E.fused(acc, cur, wr, wc, fr, fq, lds, wid, lane); S.done(cur); }
#undef PG8_SA
#undef PG8_SB
#undef PG8_STAGE
#undef PG8_LDA
#undef PG8_LDB
#undef PG8_MMA
#undef PG8_WAIT_V
#undef PG8_WAIT_L
#undef PG8_BAR
#undef PG8_SCHED
}
}

using pg8::bf16_t; using pg8::f32x4; using pg8::u32x4; using pg8::Unit;
#define LAS __attribute__((address_space(3)))

constexpr int MTOK = 32768, DM = 1024, TSEQ = 2048, NB = 16;
constexpr int INC = 6280, NPAD = 6400;
constexpr int LDS_BYTES = 163840;
constexpr size_t OFF_H    = 0;
constexpr size_t OFF_BT   = OFF_H + 67108864ull;
constexpr size_t OFF_BTIN = OFF_BT;
constexpr size_t OFF_BTA  = OFF_BTIN + 13107200ull;
constexpr size_t OFF_BTB  = OFF_BTA + 1048576ull;
constexpr size_t OFF_BTO  = OFF_BTB + 1048576ull;
constexpr size_t OFF_BTS  = OFF_BTO + 2097152ull;
constexpr size_t OFF_RSS  = OFF_BTS + 524288ull;
constexpr size_t OFF_PRKV = OFF_RSS + 131072ull;
constexpr size_t OFF_PX   = OFF_PRKV + 100663296ull;
constexpr size_t OFF_ZRW  = OFF_PX + 17825792ull;
constexpr size_t OFF_QKV  = OFF_ZRW + 33554432ull;
constexpr size_t OFF_ZGD  = OFF_QKV + 100663296ull;
constexpr size_t OFF_AP   = OFF_ZGD + 33554432ull;
constexpr size_t OFF_AA   = OFF_AP + 16777216ull;
constexpr size_t OFF_GQKV = OFF_AA + 33554432ull;
constexpr size_t OFF_BAR  = OFF_GQKV + 100663296ull;
constexpr size_t WS_END   = OFF_BAR + 16384ull;

struct Params {
    const float *x, *norm_in_w, *w_in, *rw_mu, *rw_w0, *rw_w2, *rw_a0, *rw_a2, *rw_k_k, *rw_k_a, *rw_r_k, *rw_gn_w, *rw_gn_b,
                *gd_conv_w, *gd_A_log, *gd_dt_bias, *gd_o_norm_w, *w_branch_a, *w_branch_b, *w_out, *norm_out_w;
    float* out; unsigned char* ws;
    int pad0, pad1;
};

__device__ __forceinline__ int otid() { int t = threadIdx.x; asm volatile("" : "+v"(t)); return t; }
__device__ __forceinline__ float bf2f(bf16_t v) { return __uint_as_float(((unsigned)v) << 16); }
__device__ __forceinline__ bf16_t f2bf(float f) { unsigned u = __float_as_uint(f); u += 0x7FFFu + ((u >> 16) & 1u); return (bf16_t)(u >> 16); }
__device__ __forceinline__ unsigned pk2(float lo, float hi) { return pg8::cvt_pk_bf16(lo, hi); }
__device__ __forceinline__ float wave_sum(float v) {
    v += __int_as_float(__builtin_amdgcn_update_dpp(0, __float_as_int(v), 0xB1, 0xF, 0xF, true));
    v += __int_as_float(__builtin_amdgcn_update_dpp(0, __float_as_int(v), 0x4E, 0xF, 0xF, true));
    v += __int_as_float(__builtin_amdgcn_update_dpp(0, __float_as_int(v), 0x141, 0xF, 0xF, true));
    v += __int_as_float(__builtin_amdgcn_update_dpp(0, __float_as_int(v), 0x140, 0xF, 0xF, true));
    const int iv = __float_as_int(v);
    return (__int_as_float(__builtin_amdgcn_readlane(iv, 0)) + __int_as_float(__builtin_amdgcn_readlane(iv, 16))) + (__int_as_float(__builtin_amdgcn_readlane(iv, 32)) + __int_as_float(__builtin_amdgcn_readlane(iv, 48)));
}
__device__ __forceinline__ float row_sum16(float v) {
    v += __int_as_float(__builtin_amdgcn_update_dpp(0, __float_as_int(v), 0xB1, 0xF, 0xF, true));
    v += __int_as_float(__builtin_amdgcn_update_dpp(0, __float_as_int(v), 0x4E, 0xF, 0xF, true));
    v += __int_as_float(__builtin_amdgcn_update_dpp(0, __float_as_int(v), 0x141, 0xF, 0xF, true));
    v += __int_as_float(__builtin_amdgcn_update_dpp(0, __float_as_int(v), 0x140, 0xF, 0xF, true));
    return v;
}
#define LD4(ptr) (*(const f32x4*)(ptr))
#define PIN() asm volatile("" ::: "memory")
__device__ __forceinline__ float sigmoidf_(float v) { return __builtin_amdgcn_rcpf(1.f + __expf(-v)); }
__device__ __forceinline__ float softplusf_(float v) { return fmaxf(v, 0.f) + log1pf(__expf(-fabsf(v))); }
__device__ __forceinline__ void unpack8(const u32x4 w, float (&f)[8]) {
    f[0] = __uint_as_float(w.x << 16); f[1] = __uint_as_float(w.x & 0xffff0000u); f[2] = __uint_as_float(w.y << 16); f[3] = __uint_as_float(w.y & 0xffff0000u);
    f[4] = __uint_as_float(w.z << 16); f[5] = __uint_as_float(w.z & 0xffff0000u); f[6] = __uint_as_float(w.w << 16); f[7] = __uint_as_float(w.w & 0xffff0000u);
}
__device__ __forceinline__ u32x4 pack8(const float (&f)[8]) { u32x4 w; w.x = pk2(f[0], f[1]); w.y = pk2(f[2], f[3]); w.z = pk2(f[4], f[5]); w.w = pk2(f[6], f[7]); return w; }


#define EPI_LOOP(...) \
    const int row0 = u.pm * 256 + wr * 64 + fr, col0 = u.pn * 256 + wc * 32 + 8 * fq; \
    _Pragma("unroll") for (int ai = 0; ai < 2; ++ai) _Pragma("unroll") for (int m = 0; m < 4; ++m) _Pragma("unroll") for (int bj = 0; bj < 2; ++bj) { \
        const int row = row0 + ai * 128 + m * 16, col = col0 + bj * 128; \
        const float v[8] = {acc[ai][bj][m][0][0], acc[ai][bj][m][0][1], acc[ai][bj][m][0][2], acc[ai][bj][m][0][3], acc[ai][bj][m][1][0], acc[ai][bj][m][1][1], acc[ai][bj][m][1][2], acc[ai][bj][m][1][3]}; \
        __VA_ARGS__ }
struct EpiIn {
    static constexpr bool PERM = true, AFTER_DRAIN = false, SPLIT_A = false;
    unsigned char* ws; float* gates;
    __device__ __forceinline__ void operator()(const f32x4 (&acc)[2][2][4][2], const Unit& u, int wr, int wc, int fr, int fq) const {
        const int pn = u.pn;
        if (pn == 6) {
            float* base = (float*)(ws + OFF_PX);
            EPI_LOOP( const int c = col - 1536; if (c < 136) { float* d = base + (size_t)row * 136 + c; *(f32x4*)d = (f32x4){v[0], v[1], v[2], v[3]}; *(f32x4*)(d + 4) = (f32x4){v[4], v[5], v[6], v[7]}; } )
        } else {
            bf16_t* base; int ld, coff;
            if (pn < 6) { base = (bf16_t*)(ws + OFF_PRKV); ld = 1536; coff = 0; }
            else if (pn < 9) { base = (bf16_t*)(ws + OFF_ZRW); ld = 512; coff = 1792; }
            else if (pn < 15) { base = (bf16_t*)(ws + OFF_QKV); ld = 1536; coff = 2304; }
            else if (pn < 17) { base = (bf16_t*)(ws + OFF_ZGD); ld = 512; coff = 3840; }
            else { base = (bf16_t*)gates; ld = 2048; coff = 4352; }
            EPI_LOOP( *(u32x4*)(base + (size_t)row * ld + (col - coff)) = pack8(v); )
        }
    }
};
struct EpiSmall {
    static constexpr bool PERM = true, AFTER_DRAIN = false, SPLIT_A = false;
    unsigned char* ws;
    __device__ __forceinline__ void operator()(const f32x4 (&acc)[2][2][4][2], const Unit& u, int wr, int wc, int fr, int fq) const {
        if (u.pn < 2) {
            float* base = (float*)(ws + OFF_H);
            EPI_LOOP( float* d = base + (size_t)row * 512 + col; *(f32x4*)d = (f32x4){v[0], v[1], v[2], v[3]}; *(f32x4*)(d + 4) = (f32x4){v[4], v[5], v[6], v[7]}; )
        } else {
            bf16_t* base = (bf16_t*)(ws + OFF_AA);
            EPI_LOOP( *(u32x4*)(base + (size_t)row * 512 + (col - 512)) = pack8(v); )
        }
    }
};
struct EpiC1 {
    static constexpr bool PERM = true, AFTER_DRAIN = false, SPLIT_A = false;
    unsigned char* ws; const float* gates;
    __device__ __forceinline__ void operator()(const f32x4 (&acc)[2][2][4][2], const Unit& u, int wr, int wc, int fr, int fq) const {
        const bf16_t* gb = (const bf16_t*)gates; bf16_t* m1b = (bf16_t*)(ws + OFF_PRKV);
        EPI_LOOP( float g[8], o[8]; unpack8(*(const u32x4*)(gb + (size_t)row * 2048 + col), g);
            _Pragma("unroll") for (int j = 0; j < 8; ++j) o[j] = sigmoidf_(g[j]) * v[j];
            *(u32x4*)(m1b + (size_t)row * 1024 + col) = pack8(o); )
    }
};
struct EpiC2 {
    static constexpr bool PERM = true, AFTER_DRAIN = false, SPLIT_A = false;
    unsigned char* ws; const float* gates;
    __device__ __forceinline__ void operator()(const f32x4 (&acc)[2][2][4][2], const Unit& u, int wr, int wc, int fr, int fq) const {
        const bf16_t* gb = (const bf16_t*)gates + 1024; const bf16_t* m1b = (const bf16_t*)(ws + OFF_PRKV); bf16_t* mg = (bf16_t*)(ws + OFF_GQKV);
        EPI_LOOP( float g[8], m1[8], o[8]; unpack8(*(const u32x4*)(gb + (size_t)row * 2048 + col), g); unpack8(*(const u32x4*)(m1b + (size_t)row * 1024 + col), m1);
            _Pragma("unroll") for (int j = 0; j < 8; ++j) o[j] = m1[j] + sigmoidf_(g[j]) * v[j];
            *(u32x4*)(mg + (size_t)row * 1024 + col) = pack8(o); )
    }
};
struct EpiAB {
    static constexpr bool PERM = true, AFTER_DRAIN = false, SPLIT_A = true;
    unsigned char* ws; const float* gates;
    __device__ __forceinline__ void mid(f32x4 (&acc)[2][2][4][2], const Unit& u, int wr, int wc, int fr, int fq) const {
        asm volatile("" : "+v"(fr), "+v"(fq));
        const bf16_t* gb = (const bf16_t*)gates;
        const int row0 = u.pm * 256 + wr * 64 + fr, col0 = u.pn * 256 + wc * 32 + 8 * fq;
#pragma unroll
        for (int ai = 0; ai < 2; ++ai)
#pragma unroll
            for (int mp = 0; mp < 1; ++mp) {
                u32x4 ra[4][2], rb[4][2];
#pragma unroll
                for (int mm = 0; mm < 4; ++mm)
#pragma unroll
                    for (int bj = 0; bj < 2; ++bj) { const size_t o = (size_t)(row0 + ai * 128 + (mp * 4 + mm) * 16) * 2048 + col0 + bj * 128; ra[mm][bj] = *(const u32x4*)(gb + o); rb[mm][bj] = *(const u32x4*)(gb + o + 1024); }
                PIN();
#pragma unroll
                for (int mm = 0; mm < 4; ++mm)
#pragma unroll
                    for (int bj = 0; bj < 2; ++bj) {
                        float ga[8], gv[8]; unpack8(ra[mm][bj], ga); unpack8(rb[mm][bj], gv);
                        const int m = mp * 4 + mm;
#pragma unroll
                        for (int j = 0; j < 4; ++j) {
                            acc[ai][bj][m][0][j] *= sigmoidf_(ga[j]) * (1.f + __expf(fminf(-gv[j], 80.f)));
                            acc[ai][bj][m][1][j] *= sigmoidf_(ga[4 + j]) * (1.f + __expf(fminf(-gv[4 + j], 80.f)));
                        }
                    }
                PIN();
            }
    }
    __device__ __forceinline__ void operator()(const f32x4 (&acc)[2][2][4][2], const Unit& u, int wr, int wc, int fr, int fq) const {
        asm volatile("" : "+v"(fr), "+v"(fq));
        const bf16_t* gb = (const bf16_t*)gates + 1024; bf16_t* mg = (bf16_t*)(ws + OFF_GQKV);
        const int row0 = u.pm * 256 + wr * 64 + fr, col0 = u.pn * 256 + wc * 32 + 8 * fq;
#pragma unroll
        for (int ai = 0; ai < 2; ++ai)
#pragma unroll
            for (int mp = 0; mp < 1; ++mp) {
                u32x4 rg[4][2];
#pragma unroll
                for (int mm = 0; mm < 4; ++mm)
#pragma unroll
                    for (int bj = 0; bj < 2; ++bj) rg[mm][bj] = *(const u32x4*)(gb + (size_t)(row0 + ai * 128 + (mp * 4 + mm) * 16) * 2048 + col0 + bj * 128);
                PIN();
#pragma unroll
                for (int mm = 0; mm < 4; ++mm)
#pragma unroll
                    for (int bj = 0; bj < 2; ++bj) {
                        const int m = mp * 4 + mm; float g[8], o[8]; unpack8(rg[mm][bj], g);
#pragma unroll
                        for (int j = 0; j < 4; ++j) { o[j] = sigmoidf_(g[j]) * acc[ai][bj][m][0][j]; o[4 + j] = sigmoidf_(g[4 + j]) * acc[ai][bj][m][1][j]; }
                        *(u32x4*)(mg + (size_t)(row0 + ai * 128 + m * 16) * 1024 + col0 + bj * 128) = pack8(o);
                    }
                PIN();
            }
    }
};
struct EpiC3 {
    static constexpr bool PERM = true, AFTER_DRAIN = false, SPLIT_A = false;
    const float* x; float* out; float* rss;
    __device__ __forceinline__ void operator()(const f32x4 (&acc)[2][2][4][2], const Unit& u, int wr, int wc, int fr, int fq) const {
        asm volatile("" : "+v"(fr), "+v"(fq));
        const int row0 = u.pm * 256 + wr * 64 + fr, col0 = u.pn * 256 + wc * 32 + 8 * fq;
#pragma unroll
        for (int ai = 0; ai < 2; ++ai)
#pragma unroll
            for (int mp = 0; mp < 1; ++mp) {
                f32x4 xa[4][2], xb[4][2];
#pragma unroll
                for (int mm = 0; mm < 4; ++mm)
#pragma unroll
                    for (int bj = 0; bj < 2; ++bj) { const size_t o = (size_t)(row0 + ai * 128 + (mp * 4 + mm) * 16) * 1024 + col0 + bj * 128; xa[mm][bj] = *(const f32x4*)(x + o); xb[mm][bj] = *(const f32x4*)(x + o + 4); }
                PIN();
#pragma unroll
                for (int mm = 0; mm < 4; ++mm) {
                    const int m = mp * 4 + mm, row = row0 + ai * 128 + m * 16; float ss = 0.f;
#pragma unroll
                    for (int bj = 0; bj < 2; ++bj) {
                        const size_t o = (size_t)row * 1024 + col0 + bj * 128;
                        const f32x4 a = xa[mm][bj] + acc[ai][bj][m][0], b = xb[mm][bj] + acc[ai][bj][m][1];
                        *(f32x4*)(out + o) = a; *(f32x4*)(out + o + 4) = b;
                        ss += a[0] * a[0] + a[1] * a[1] + a[2] * a[2] + a[3] * a[3] + b[0] * b[0] + b[1] * b[1] + b[2] * b[2] + b[3] * b[3];
                    }
                    ss += __shfl_xor(ss, 16); ss += __shfl_xor(ss, 32);
                    if (fq == 0) atomicAdd(rss + row, ss);
                }
                PIN();
            }
    }
};

__device__ __forceinline__ int in_src_col(int n) {
    if (n < 1664) return n;
    if (n < 1672) return 4224 + (n - 1664);
    if (n < 1792) return -1;
    if (n < 2304) return 1664 + (n - 1792);
    if (n < 3840) return 2176 + (n - 2304);
    if (n < 4352) return 3712 + (n - 3840);
    return 4232 + (n - 4352);
}
template <int WHICH> __device__ __forceinline__ float wsrc(const Params& p, int n, int k) {
    if (WHICH == 0) { const int s = in_src_col(n); return s >= 0 ? p.w_in[(size_t)k * INC + s] : 0.f; }
    if (WHICH == 1) return k < 512 ? p.w_branch_a[(size_t)k * 1024 + n] : p.w_branch_b[(size_t)(k - 512) * 1024 + n];
    if (WHICH == 3) return p.w_out[(size_t)k * 1024 + n];
    if (n < 512) return k < 64 ? p.rw_w2[k * 512 + n] : 0.f;
    return (k >= 64 && k < 128) ? p.rw_a2[(k - 64) * 512 + (n - 512)] : 0.f;
}
template <int WHICH> __device__ __forceinline__ void transpose_tile(const Params& p, float* lds, bf16_t* Bt, int K, int n0, int k0) {
    const int tid = otid(), c = tid & 63, r = tid >> 6;
    float v[8];
#pragma unroll
    for (int q = 0; q < 8; ++q) v[q] = wsrc<WHICH>(p, n0 + c, k0 + r + 8 * q);
    __syncthreads();
#pragma unroll
    for (int q = 0; q < 8; ++q) lds[(r + 8 * q) * 65 + c] = v[q];
    __syncthreads();
#pragma unroll
    for (int q = 0; q < 8; ++q) Bt[(size_t)(n0 + r + 8 * q) * K + k0 + c] = f2bf(lds[c * 65 + r + 8 * q]);
}
__device__ void later_weight_tiles(const Params& p, float* lds, int rank, int n) {
    for (int t = 1600 + rank; t < 2176; t += n) {
        if (t < 1856) { const int u = t - 1600; transpose_tile<1>(p, lds, (bf16_t*)(p.ws + OFF_BTA), 1024, (u >> 4) * 64, (u & 15) * 64); }
        else if (t < 2112) { const int u = t - 1856; transpose_tile<3>(p, lds, (bf16_t*)(p.ws + OFF_BTO), 1024, (u >> 4) * 64, (u & 15) * 64); }
        else { const int u = t - 2112; transpose_tile<4>(p, lds, (bf16_t*)(p.ws + OFF_BTS), 256, (u >> 2) * 64, (u & 3) * 64); }
    }
}
__device__ void phase0(const Params& p, float* lds) {
    const int tid = otid(), lane = tid & 63, gw = blockIdx.x * 8 + (tid >> 6), nw = gridDim.x * 8;
    bf16_t* H = (bf16_t*)(p.ws + OFF_H);
    f32x4 gq[4];
#pragma unroll
    for (int i = 0; i < 4; ++i) gq[i] = *(const f32x4*)(p.norm_in_w + lane * 16 + i * 4);
    for (int r0 = gw; r0 < MTOK; r0 += 4 * nw) {
        f32x4 a[4][4];
#pragma unroll
        for (int q = 0; q < 4; ++q) { const int row = min(r0 + q * nw, MTOK - 1);
#pragma unroll
            for (int i = 0; i < 4; ++i) a[q][i] = *(const f32x4*)(p.x + (size_t)row * 1024 + lane * 16 + i * 4); }
        PIN();
#pragma unroll
        for (int q = 0; q < 4; ++q) {
            const int row = r0 + q * nw; if (row >= MTOK) break;
            float ss = 0.f;
#pragma unroll
            for (int i = 0; i < 4; ++i) ss += a[q][i][0] * a[q][i][0] + a[q][i][1] * a[q][i][1] + a[q][i][2] * a[q][i][2] + a[q][i][3] * a[q][i][3];
            ss = wave_sum(ss);
            const float rs = rsqrtf(ss * (1.f / 1024.f) + 1e-6f);
            float o[16];
#pragma unroll
            for (int i = 0; i < 4; ++i)
#pragma unroll
                for (int j = 0; j < 4; ++j) o[i * 4 + j] = a[q][i][j] * rs * gq[i][j];
            u32x4 w0, w1; w0.x = pk2(o[0], o[1]); w0.y = pk2(o[2], o[3]); w0.z = pk2(o[4], o[5]); w0.w = pk2(o[6], o[7]);
            w1.x = pk2(o[8], o[9]); w1.y = pk2(o[10], o[11]); w1.z = pk2(o[12], o[13]); w1.w = pk2(o[14], o[15]);
            *(u32x4*)(H + (size_t)row * 1024 + lane * 16) = w0; *(u32x4*)(H + (size_t)row * 1024 + lane * 16 + 8) = w1;
        }
    }
    for (int t = blockIdx.x; t < 1600; t += gridDim.x) transpose_tile<0>(p, lds, (bf16_t*)(p.ws + OFF_BTIN), 1024, (t >> 4) * 64, (t & 15) * 64);
    float* rss = (float*)(p.ws + OFF_RSS);
    for (int i = blockIdx.x * 512 + tid; i < MTOK; i += gridDim.x * 512) rss[i] = 0.f;
}

__device__ void phase2(const Params& p) {
    const int tid = otid(), lane = tid & 63;
    const float* PX = (const float*)(p.ws + OFF_PX);
    bf16_t* AP = (bf16_t*)(p.ws + OFF_AP);
    for (int task = blockIdx.x * 512 + tid; task < (MTOK / 16) * 128; task += gridDim.x * 512) {
        const int j = task & 127, m0 = (task >> 7) * 16;
        float v[17];
        v[0] = (m0 & (TSEQ - 1)) ? PX[(size_t)(m0 - 1) * 136 + j] : 0.f;
#pragma unroll
        for (int t = 0; t < 16; ++t) v[t + 1] = PX[(size_t)(m0 + t) * 136 + j];
        PIN();
        const float mu = p.rw_mu[1536 + j];
#pragma unroll
        for (int t = 0; t < 16; ++t) {
            float xs = v[t + 1] + (v[t] - v[t + 1]) * mu;
            if (j < 64) xs = tanhf(xs);
            AP[(size_t)(m0 + t) * 256 + j] = f2bf(xs); AP[(size_t)(m0 + t) * 256 + 128 + j] = 0;
        }
    }
    const bf16_t* QKV = (const bf16_t*)(p.ws + OFF_QKV);
    bf16_t* GQ = (bf16_t*)(p.ws + OFF_GQKV);
    const int gw = blockIdx.x * 8 + (tid >> 6), nw = gridDim.x * 8;
    for (int task = gw; task < (MTOK / 16) * 3; task += nw) {
        const int grp = task % 3, m0 = (task / 3) * 16;
        const int ch = grp * 512 + lane * 8;
        float cw[4][8];
#pragma unroll
        for (int i = 0; i < 4; ++i) { const f32x4 a = *(const f32x4*)(p.gd_conv_w + i * 1536 + ch), b = *(const f32x4*)(p.gd_conv_w + i * 1536 + ch + 4);
#pragma unroll
            for (int j = 0; j < 4; ++j) { cw[i][j] = a[j]; cw[i][4 + j] = b[j]; } }
        float x1[8], x2[8], x3[8];
        if (m0 & (TSEQ - 1)) {
            unpack8(*(const u32x4*)(QKV + (size_t)(m0 - 1) * 1536 + ch), x1); unpack8(*(const u32x4*)(QKV + (size_t)(m0 - 2) * 1536 + ch), x2); unpack8(*(const u32x4*)(QKV + (size_t)(m0 - 3) * 1536 + ch), x3);
        } else {
#pragma unroll
            for (int j = 0; j < 8; ++j) { x1[j] = 0.f; x2[j] = 0.f; x3[j] = 0.f; }
        }
        u32x4 raw[16];
#pragma unroll
        for (int t = 0; t < 16; ++t) raw[t] = *(const u32x4*)(QKV + (size_t)(m0 + t) * 1536 + ch);
        PIN();
#pragma unroll
        for (int t = 0; t < 16; ++t) {
            const int m = m0 + t; float x0[8], y[8]; unpack8(raw[t], x0);
            float ss = 0.f;
#pragma unroll
            for (int j = 0; j < 8; ++j) { const float c = cw[0][j] * x3[j] + cw[1][j] * x2[j] + cw[2][j] * x1[j] + cw[3][j] * x0[j]; y[j] = c * sigmoidf_(c); ss += y[j] * y[j]; x3[j] = x2[j]; x2[j] = x1[j]; x1[j] = x0[j]; }
            if (grp < 2) {
                ss = row_sum16(ss);
                const float sc = rsqrtf(ss + 1e-12f);
#pragma unroll
                for (int j = 0; j < 8; ++j) y[j] *= sc;
            }
            *(u32x4*)(GQ + (size_t)m * 1536 + ch) = pack8(y);
        }
    }
}

typedef float f32x2 __attribute__((ext_vector_type(2)));
#define LO2(v4) __builtin_shufflevector(v4, v4, 0, 1)
#define HI2(v4) __builtin_shufflevector(v4, v4, 2, 3)
#define FMA2(a, b, c) __builtin_elementwise_fma(a, b, c)
__device__ __forceinline__ float dot8(const f32x2 (&S2)[4], const f32x4 a, const f32x4 b) {
    f32x2 t = S2[0] * LO2(a); t = FMA2(S2[1], HI2(a), t); t = FMA2(S2[2], LO2(b), t); t = FMA2(S2[3], HI2(b), t); return t.x + t.y;
}
__device__ __forceinline__ float sum8(float v) {
    v += __int_as_float(__builtin_amdgcn_update_dpp(0, __float_as_int(v), 0xB1, 0xF, 0xF, true));
    v += __int_as_float(__builtin_amdgcn_update_dpp(0, __float_as_int(v), 0x4E, 0xF, 0xF, true));
    v += __int_as_float(__builtin_amdgcn_update_dpp(0, __float_as_int(v), 0x141, 0xF, 0xF, true));
    return v;
}
#define DPPADD(v, ctrl) v += __int_as_float(__builtin_amdgcn_update_dpp(0, __float_as_int(v), ctrl, 0xF, 0xF, true))
__device__ __forceinline__ void sum8x4(float& a, float& b, float& c, float& d) {
    DPPADD(a, 0xB1); DPPADD(b, 0xB1); DPPADD(c, 0xB1); DPPADD(d, 0xB1);
    DPPADD(a, 0x4E); DPPADD(b, 0x4E); DPPADD(c, 0x4E); DPPADD(d, 0x4E);
    DPPADD(a, 0x141); DPPADD(b, 0x141); DPPADD(c, 0x141); DPPADD(d, 0x141);
}
#define RWKV_LOAD(T0, W, CH) do { const size_t mw_ = (size_t)b * TSEQ + (T0) + 8 * (W); \
        if ((T0) + 8 * (W) > 0) { pr[0] = bf2f(PRKV[(mw_ - 1) * 1536 + (CH)]); pk[0] = bf2f(PRKV[(mw_ - 1) * 1536 + 512 + (CH)]); pv[0] = bf2f(PRKV[(mw_ - 1) * 1536 + 1024 + (CH)]); } \
        else { pr[0] = 0.f; pk[0] = 0.f; pv[0] = 0.f; } \
        _Pragma("unroll") for (int i = 0; i < 8; ++i) { const size_t m = mw_ + i; pr[i + 1] = bf2f(PRKV[m * 1536 + (CH)]); pk[i + 1] = bf2f(PRKV[m * 1536 + 512 + (CH)]); pv[i + 1] = bf2f(PRKV[m * 1536 + 1024 + (CH)]); \
            aa[i] = bf2f(AA[m * 512 + (CH)]); dd[i] = DEC[m * 512 + (CH)]; } } while (0)
__device__ void rwkv_scan(const Params& p, float* lds, int task) {
    const int b = task >> 3, h = task & 7, tid = otid(), w_ = tid >> 6, lane_ = tid & 63;
    constexpr int LD = 68;
    float *AT = lds, *QT = AT + 64 * LD, *BT = QT + 64 * LD, *KT = BT + 64 * LD, *G8 = KT + 64 * LD, *Vv0 = G8 + 512, *CF = Vv0 + 4096, *RED = CF + 2048, *YACC = RED + 8192, *BON0 = YACC + 4096;
    const bf16_t* PRKV = (const bf16_t*)(p.ws + OFF_PRKV); const bf16_t* AA = (const bf16_t*)(p.ws + OFF_AA); const float* DEC = (const float*)(p.ws + OFF_H);
    const bf16_t* ZRW = (const bf16_t*)(p.ws + OFF_ZRW); bf16_t* YA = (bf16_t*)(p.ws + OFF_QKV);
    f32x2 S2[4];
#pragma unroll
    for (int j = 0; j < 4; ++j) S2[j] = (f32x2){0.f, 0.f};
#pragma unroll
    for (int mq_ = 0; mq_ < 4; ++mq_) CF[(w_ * 4 + mq_) * 64 + lane_] = 0.f;
    float pr[9], pk[9], pv[9], aa[8], dd[8];
    RWKV_LOAD(0, w_, h * 64 + lane_);
    for (int blk = 0; blk < TSEQ / 64; ++blk) {
        const int t0 = blk * 64;
        float* const Vv = (blk & 1) ? RED : Vv0; float* const BON = (blk & 1) ? RED + 4096 : BON0;
        int w = w_, lane = lane_; asm volatile("" : "+v"(w), "+v"(lane));
        const int ch = h * 64 + lane;
        {
            const float mu_r = p.rw_mu[ch], mu_k = p.rw_mu[512 + ch], mu_v = p.rw_mu[1024 + ch], kkc = p.rw_k_k[ch], kac = p.rw_k_a[ch], rkc = p.rw_r_k[ch], w0c = p.rw_w0[ch], a0c = p.rw_a0[ch];
            float G = 1.f;
#pragma unroll
            for (int i = 0; i < 8; ++i) {
                const int s = 8 * w + i;
                const float r = pr[i + 1] + (pr[i] - pr[i + 1]) * mu_r, k = pk[i + 1] + (pk[i] - pk[i + 1]) * mu_k, v = pv[i + 1] + (pv[i] - pv[i + 1]) * mu_v;
                const float a = sigmoidf_(a0c + aa[i]), dec = __expf(-0.6065306597f * sigmoidf_(w0c + dd[i]));
                const float kkr = k * kkc; const float ssq = wave_sum(kkr * kkr); const float kk = kkr * rsqrtf(ssq + 1e-12f);
                const float kp = k * (1.f + (a - 1.f) * kac);
                const float bon = wave_sum(r * kp * rkc);
                const float Gp = G; G *= dec; const float iG = __builtin_amdgcn_rcpf(G);
                AT[s * LD + lane] = -kk * Gp; QT[s * LD + lane] = r * G; BT[s * LD + lane] = kk * a * iG; KT[s * LD + lane] = kp * iG; Vv[s * 64 + lane] = v;
                if (lane == 0) BON[s] = bon;
            }
            G8[w * 64 + lane] = G;
            const bool isM = lane < 36; const int idx = isM ? lane : lane - 36;
            const int tt_ = (idx >= 1) + (idx >= 3) + (idx >= 6) + (idx >= 10) + (idx >= 15) + (idx >= 21) + (idx >= 28);
            const int tq = isM ? tt_ : tt_ + 1, jq = idx - tt_ * (tt_ + 1) / 2;
            const float *rt = (isM ? QT : AT) + (8 * w + tq) * LD, *bj = BT + (8 * w + jq) * LD, *kj = KT + (8 * w + jq) * LD;
            float db = 0.f, dk = 0.f;
#pragma unroll 1
            for (int c = 0; c < 64; c += 16) {
                f32x4 a4[4], b4[4], k4[4];
#pragma unroll
                for (int i = 0; i < 4; ++i) { a4[i] = LD4(rt + c + 4 * i); b4[i] = LD4(bj + c + 4 * i); k4[i] = LD4(kj + c + 4 * i); }
                PIN();
#pragma unroll
                for (int i = 0; i < 4; ++i)
#pragma unroll
                    for (int e = 0; e < 4; ++e) { db += a4[i][e] * b4[i][e]; dk += a4[i][e] * k4[i][e]; }
            }
            CF[(w * 4 + (isM ? 2 : 0)) * 64 + tq * 8 + jq] = db; CF[(w * 4 + (isM ? 3 : 1)) * 64 + tq * 8 + jq] = dk;
        }
        __syncthreads();
        if (blk + 1 < TSEQ / 64) RWKV_LOAD(t0 + 64, w, ch);
        const int r = lane >> 3, ko = lane & 7;
        for (int mb = 0; mb < 8; ++mb) {
            float u[8], vv[8], pq[8];
            int cfo = mb * 256; asm volatile("" : "+v"(cfo));
            const float* cf = CF + cfo;
            f32x4 DA[2][8];
#define RW_LD_DOTS(buf, tp) do { const float *ap_ = AT + (mb * 8 + (tp) * 2) * LD + ko * 8, *qp_ = QT + (mb * 8 + (tp) * 2) * LD + ko * 8; \
                DA[buf][0] = LD4(ap_); DA[buf][1] = LD4(ap_ + 4); DA[buf][2] = LD4(ap_ + LD); DA[buf][3] = LD4(ap_ + LD + 4); DA[buf][4] = LD4(qp_); DA[buf][5] = LD4(qp_ + 4); DA[buf][6] = LD4(qp_ + LD); DA[buf][7] = LD4(qp_ + LD + 4); } while (0)
            RW_LD_DOTS(0, 0);
            f32x4 La[4], Ka[4];
#pragma unroll
            for (int tp = 0; tp < 4; ++tp) {
                if (tp < 3) RW_LD_DOTS((tp + 1) & 1, tp + 1);
                else {
#pragma unroll
                    for (int t = 0; t < 8; ++t) vv[t] = Vv[(mb * 8 + t) * 64 + w * 8 + r];
#pragma unroll
                    for (int t = 1; t < 4; ++t) { La[t] = LD4(cf + t * 8); Ka[t] = LD4(cf + 64 + t * 8); }
                }
                PIN();
                u[tp * 2] = dot8(S2, DA[tp & 1][0], DA[tp & 1][1]); u[tp * 2 + 1] = dot8(S2, DA[tp & 1][2], DA[tp & 1][3]);
                pq[tp * 2] = dot8(S2, DA[tp & 1][4], DA[tp & 1][5]); pq[tp * 2 + 1] = dot8(S2, DA[tp & 1][6], DA[tp & 1][7]);
                sum8x4(u[tp * 2], u[tp * 2 + 1], pq[tp * 2], pq[tp * 2 + 1]);
            }
#undef RW_LD_DOTS
            f32x4 L0[4], L1[4], K0[4], K1[4];
#pragma unroll
            for (int t = 0; t < 4; ++t) { L0[t] = LD4(cf + (4 + t) * 8); L1[t] = LD4(cf + (4 + t) * 8 + 4); K0[t] = LD4(cf + 64 + (4 + t) * 8); K1[t] = LD4(cf + 64 + (4 + t) * 8 + 4); }
            PIN();
#pragma unroll
            for (int t = 1; t < 4; ++t) { float x = u[t];
#pragma unroll
                for (int j = 0; j < 3; ++j) if (j < t) x += La[t][j] * u[j] + Ka[t][j] * vv[j];
                u[t] = x; }
            const f32x4 m0 = LD4(cf + 128 + ko * 8), m1 = LD4(cf + 128 + ko * 8 + 4), n0 = LD4(cf + 192 + ko * 8), n1 = LD4(cf + 192 + ko * 8 + 4);
            f32x4 UB[2][8];
#define RW_LD_UPD(buf, jp) do { const float *bp_ = BT + (mb * 8 + (jp) * 2) * LD + ko * 8, *kp_ = KT + (mb * 8 + (jp) * 2) * LD + ko * 8; \
                UB[buf][0] = LD4(bp_); UB[buf][1] = LD4(bp_ + 4); UB[buf][2] = LD4(bp_ + LD); UB[buf][3] = LD4(bp_ + LD + 4); UB[buf][4] = LD4(kp_); UB[buf][5] = LD4(kp_ + 4); UB[buf][6] = LD4(kp_ + LD); UB[buf][7] = LD4(kp_ + LD + 4); } while (0)
            RW_LD_UPD(0, 0);
            PIN();
#pragma unroll
            for (int t = 0; t < 4; ++t) { float x = u[4 + t];
#pragma unroll
                for (int j = 0; j < 4; ++j) { x += L0[t][j] * u[j] + K0[t][j] * vv[j]; if (j < t) x += L1[t][j] * u[4 + j] + K1[t][j] * vv[4 + j]; }
                u[4 + t] = x; }
            {
                float yc = pq[0];
#pragma unroll
                for (int t = 1; t < 8; ++t) yc = (ko == t) ? pq[t] : yc;
#pragma unroll
                for (int j = 0; j < 4; ++j) yc += m0[j] * u[j] + n0[j] * vv[j] + m1[j] * u[4 + j] + n1[j] * vv[4 + j];
                YACC[(mb * 8 + ko) * 64 + w * 8 + r] = yc;
            }
            f32x2 acc[4];
#pragma unroll
            for (int k = 0; k < 4; ++k) acc[k] = S2[k];
            f32x4 g0, g1;
#pragma unroll
            for (int jp = 0; jp < 4; ++jp) {
                if (jp < 3) RW_LD_UPD((jp + 1) & 1, jp + 1);
                else { g0 = LD4(G8 + mb * 64 + ko * 8); g1 = LD4(G8 + mb * 64 + ko * 8 + 4); }
                PIN();
                const f32x4 B0 = UB[jp & 1][0], B1 = UB[jp & 1][1], B2 = UB[jp & 1][2], B3 = UB[jp & 1][3], C0 = UB[jp & 1][4], C1 = UB[jp & 1][5], C2 = UB[jp & 1][6], C3 = UB[jp & 1][7];
                const f32x2 ua = (f32x2){u[jp * 2], u[jp * 2]}, ub = (f32x2){u[jp * 2 + 1], u[jp * 2 + 1]}, va = (f32x2){vv[jp * 2], vv[jp * 2]}, vb = (f32x2){vv[jp * 2 + 1], vv[jp * 2 + 1]};
                acc[0] = FMA2(LO2(B0), ua, acc[0]); acc[1] = FMA2(HI2(B0), ua, acc[1]); acc[2] = FMA2(LO2(B1), ua, acc[2]); acc[3] = FMA2(HI2(B1), ua, acc[3]);
                acc[0] = FMA2(LO2(C0), va, acc[0]); acc[1] = FMA2(HI2(C0), va, acc[1]); acc[2] = FMA2(LO2(C1), va, acc[2]); acc[3] = FMA2(HI2(C1), va, acc[3]);
                acc[0] = FMA2(LO2(B2), ub, acc[0]); acc[1] = FMA2(HI2(B2), ub, acc[1]); acc[2] = FMA2(LO2(B3), ub, acc[2]); acc[3] = FMA2(HI2(B3), ub, acc[3]);
                acc[0] = FMA2(LO2(C2), vb, acc[0]); acc[1] = FMA2(HI2(C2), vb, acc[1]); acc[2] = FMA2(LO2(C3), vb, acc[2]); acc[3] = FMA2(HI2(C3), vb, acc[3]);
            }
#undef RW_LD_UPD
            S2[0] = LO2(g0) * acc[0]; S2[1] = HI2(g0) * acc[1]; S2[2] = LO2(g1) * acc[2]; S2[3] = HI2(g1) * acc[3];
        }
        __syncthreads();
        asm volatile("" : "+v"(w), "+v"(lane));
        const int ch2 = h * 64 + lane;
        const float gnw = p.rw_gn_w[ch2], gnb = p.rw_gn_b[ch2];
        float zz[8];
#pragma unroll
        for (int i = 0; i < 8; ++i) zz[i] = bf2f(ZRW[((size_t)b * TSEQ + t0 + w + 8 * i) * 512 + ch2]);
#pragma unroll
        for (int i = 0; i < 8; ++i) {
            const int s = w + 8 * i; const size_t m = (size_t)b * TSEQ + t0 + s;
            const float y = YACC[s * 64 + lane];
            const float mean = wave_sum(y) * (1.f / 64.f); const float d = y - mean; const float var = wave_sum(d * d) * (1.f / 64.f);
            const float o = d * rsqrtf(var + 64e-5f) * gnw + gnb + BON[s] * Vv[s * 64 + lane];
            const float z = zz[i];
            YA[m * 512 + ch2] = f2bf(o * z * sigmoidf_(z));
        }
    }
}
#define GDN_LOAD(MB0, TID) do { \
        _Pragma("unroll") for (int i = 0; i < 2; ++i) { const int cidx = (TID) + i * 512, s = cidx >> 4, j = (cidx & 15) * 8; const size_t o = ((MB0) + s) * 1536 + h * 128 + j; \
            rq[i] = *(const u32x4*)(GQ + o); rk[i] = *(const u32x4*)(GQ + o + 512); } \
        { const int s = (TID) >> 3, c = ((TID) & 7) * 8; rv = *(const u32x4*)(GQ + ((MB0) + s) * 1536 + 1024 + h * 128 + half * 64 + c); } \
        { const float* px = PX + ((MB0) + ((TID) & 63)) * 136; pxb = px[128 + h]; pxa = px[132 + h]; } } while (0)
__device__ void gdn_scan(const Params& p, float* lds, int task) {
    const int half = task & 1, h = (task >> 1) & 3, b = task >> 3, tid_ = otid();
    constexpr int LD = 132;
    float *Q = lds, *K = Q + 64 * LD, *V = K + 64 * LD, *CF = V + 4096, *RED = CF + 1024, *OACC = RED + 8192, *LG = OACC + 4096, *BE = LG + 64, *EG = BE + 64, *ER = EG + 64;
    const bf16_t* GQ = (const bf16_t*)(p.ws + OFF_GQKV); const float* PX = (const float*)(p.ws + OFF_PX);
    float* OB = (float*)(p.ws + OFF_QKV + 33554432ull);
    const float nA = -__expf(p.gd_A_log[h]), dtb = p.gd_dt_bias[h];
    f32x2 S2[8];
#pragma unroll
    for (int j = 0; j < 8; ++j) S2[j] = (f32x2){0.f, 0.f};
    { const int w0_ = tid_ >> 6, l0_ = tid_ & 63; CF[(w0_ * 2) * 64 + l0_] = 0.f; CF[(w0_ * 2 + 1) * 64 + l0_] = 0.f; }
    u32x4 rq[2], rk[2], rv; float pxb, pxa;
    GDN_LOAD((size_t)b * TSEQ, tid_);
    for (int blk = 0; blk < TSEQ / 64; ++blk) {
        const size_t mb0 = (size_t)b * TSEQ + blk * 64;
        int tid = tid_; asm volatile("" : "+v"(tid));
        const int w = tid >> 6, lane = tid & 63;
        {
#pragma unroll
            for (int i = 0; i < 2; ++i) { const int cidx = tid + i * 512, s = cidx >> 4, j = (cidx & 15) * 8; float f[8];
                unpack8(rq[i], f);
                *(f32x4*)(Q + s * LD + j) = (f32x4){f[0], f[1], f[2], f[3]} * 0.08838834764831845f; *(f32x4*)(Q + s * LD + j + 4) = (f32x4){f[4], f[5], f[6], f[7]} * 0.08838834764831845f;
                unpack8(rk[i], f);
                *(f32x4*)(K + s * LD + j) = (f32x4){f[0], f[1], f[2], f[3]}; *(f32x4*)(K + s * LD + j + 4) = (f32x4){f[4], f[5], f[6], f[7]}; }
            { const int s = tid >> 3, c = (tid & 7) * 8; float f[8]; unpack8(rv, f);
                *(f32x4*)(V + s * 64 + c) = (f32x4){f[0], f[1], f[2], f[3]}; *(f32x4*)(V + s * 64 + c + 4) = (f32x4){f[4], f[5], f[6], f[7]}; }
        }
        if (tid < 64) {
            BE[tid] = sigmoidf_(pxb);
            float c = nA * softplusf_(pxa + dtb);
#pragma unroll
            for (int off = 1; off < 4; off <<= 1) { const float n = __shfl_up(c, off); if ((tid & 3) >= off) c += n; }
            LG[tid] = c; EG[tid] = __expf(c);
            const float cend = __shfl(c, tid | 3); ER[tid] = __expf(cend - c);
        }
        __syncthreads();
        {
            const int hf = lane & 1, pidx = lane >> 1, gq = pidx >> 4, q = pidx & 15;
            const bool isM = q < 10; const int rr = isM ? q : q - 10;
            const int tt_ = isM ? ((rr >= 1) + (rr >= 3) + (rr >= 6)) : ((rr >= 1) + (rr >= 3));
            const int t4 = isM ? tt_ : tt_ + 1, j4 = rr - tt_ * (tt_ + 1) / 2;
            const int st = 8 * w + 4 * gq + t4, sj = 8 * w + 4 * gq + j4;
            const float *ra = (isM ? Q : K) + st * LD + hf * 64, *rb = K + sj * LD + hf * 64;
            float dsum = 0.f;
#pragma unroll
            for (int c = 0; c < 64; c += 32) {
                f32x4 a4[8], b4[8];
#pragma unroll
                for (int i = 0; i < 8; ++i) { a4[i] = LD4(ra + c + 4 * i); b4[i] = LD4(rb + c + 4 * i); }
                PIN();
#pragma unroll
                for (int i = 0; i < 8; ++i)
#pragma unroll
                    for (int e = 0; e < 4; ++e) dsum += a4[i][e] * b4[i][e];
            }
            DPPADD(dsum, 0xB1);
            const float ratio = __expf(fminf(LG[st] - LG[sj], 0.f));
            const float val = isM ? ratio * dsum : BE[st] * ratio * dsum;
            if (hf == 0) CF[(w * 2 + (isM ? 1 : 0)) * 64 + (4 * gq + t4) * 8 + 4 * gq + j4] = val;
        }
        __syncthreads();
        if (blk + 1 < TSEQ / 64) GDN_LOAD(mb0 + 64, tid);
        const int r = lane >> 3, ko = lane & 7;
        for (int g = 0; g < 16; ++g) {
            const int s0 = g * 4, hb = (g & 1) * 4;
            const float *kp = K + s0 * LD + ko * 16, *qp = Q + s0 * LD + ko * 16;
            f32x4 KK[4][4];
            float d[4], c[4], pe[4];
#pragma unroll
            for (int tp = 0; tp < 2; ++tp) {
                f32x4 QQ[2][4];
#pragma unroll
                for (int t = 0; t < 2; ++t)
#pragma unroll
                    for (int j = 0; j < 4; ++j) { KK[tp * 2 + t][j] = LD4(kp + (tp * 2 + t) * LD + j * 4); QQ[t][j] = LD4(qp + (tp * 2 + t) * LD + j * 4); }
                PIN();
                f32x2 x0 = S2[0] * LO2(KK[tp * 2][0]), y0 = S2[0] * LO2(QQ[0][0]), x1 = S2[0] * LO2(KK[tp * 2 + 1][0]), y1 = S2[0] * LO2(QQ[1][0]);
                x0 = FMA2(S2[1], HI2(KK[tp * 2][0]), x0); y0 = FMA2(S2[1], HI2(QQ[0][0]), y0); x1 = FMA2(S2[1], HI2(KK[tp * 2 + 1][0]), x1); y1 = FMA2(S2[1], HI2(QQ[1][0]), y1);
#pragma unroll
                for (int j = 1; j < 4; ++j) {
                    x0 = FMA2(S2[2 * j], LO2(KK[tp * 2][j]), x0); y0 = FMA2(S2[2 * j], LO2(QQ[0][j]), y0); x1 = FMA2(S2[2 * j], LO2(KK[tp * 2 + 1][j]), x1); y1 = FMA2(S2[2 * j], LO2(QQ[1][j]), y1);
                    x0 = FMA2(S2[2 * j + 1], HI2(KK[tp * 2][j]), x0); y0 = FMA2(S2[2 * j + 1], HI2(QQ[0][j]), y0); x1 = FMA2(S2[2 * j + 1], HI2(KK[tp * 2 + 1][j]), x1); y1 = FMA2(S2[2 * j + 1], HI2(QQ[1][j]), y1);
                }
                d[tp * 2] = x0.x + x0.y; d[tp * 2 + 1] = x1.x + x1.y; pe[tp * 2] = y0.x + y0.y; pe[tp * 2 + 1] = y1.x + y1.y;
                sum8x4(d[tp * 2], d[tp * 2 + 1], pe[tp * 2], pe[tp * 2 + 1]);
            }
            float eg[4], er[4], be[4];
#pragma unroll
            for (int t = 0; t < 4; ++t) { c[t] = V[(s0 + t) * 64 + w * 8 + r]; eg[t] = EG[s0 + t]; er[t] = ER[s0 + t]; be[t] = BE[s0 + t]; }
            int cfo = (g >> 1) * 128; asm volatile("" : "+v"(cfo));
            const float* cf = CF + cfo;
            {
                f32x4 L[4];
#pragma unroll
                for (int t = 1; t < 4; ++t) L[t] = LD4(cf + (hb + t) * 8 + hb);
                const f32x4 mq = LD4(cf + 64 + (hb + (ko & 3)) * 8 + hb);
                PIN();
#pragma unroll
                for (int t = 0; t < 4; ++t) {
                    float x = be[t] * (c[t] - eg[t] * d[t]);
#pragma unroll
                    for (int j = 0; j < 3; ++j) if (j < t) x -= L[t < 1 ? 1 : t][j] * c[j];
                    c[t] = x;
                }
                float oc = eg[0] * pe[0];
#pragma unroll
                for (int t = 1; t < 4; ++t) oc = ((ko & 3) == t) ? eg[t] * pe[t] : oc;
#pragma unroll
                for (int j = 0; j < 4; ++j) oc += mq[j] * c[j];
                if (ko < 4) OACC[(s0 + ko) * 64 + w * 8 + r] = oc;
            }
            const f32x2 g4 = (f32x2){eg[3], eg[3]};
#pragma unroll
            for (int k = 0; k < 8; ++k) S2[k] *= g4;
#pragma unroll
            for (int t = 0; t < 4; ++t) {
                const float cs = er[t] * c[t]; const f32x2 c2 = (f32x2){cs, cs};
#pragma unroll
                for (int q = 0; q < 4; ++q) { S2[2 * q] = FMA2(LO2(KK[t][q]), c2, S2[2 * q]); S2[2 * q + 1] = FMA2(HI2(KK[t][q]), c2, S2[2 * q + 1]); }
            }
        }
        __syncthreads();
        for (int idx = tid; idx < 4096; idx += 512) { const int s = idx >> 6, c = idx & 63; OB[(mb0 + s) * 512 + h * 128 + half * 64 + c] = OACC[idx]; }
    }
}
__device__ void phase35(const Params& p) {
    const int tid = otid(), lane = tid & 63, gw = blockIdx.x * 8 + (tid >> 6), nw = gridDim.x * 8;
    const float* OB = (const float*)(p.ws + OFF_QKV + 33554432ull); const bf16_t* ZGD = (const bf16_t*)(p.ws + OFF_ZGD); bf16_t* YB = (bf16_t*)(p.ws + OFF_AA);
    float onw[8];
#pragma unroll
    for (int j = 0; j < 8; ++j) onw[j] = p.gd_o_norm_w[(lane * 8 + j) & 127];
    for (int m0 = gw; m0 < MTOK; m0 += 4 * nw) {
        f32x4 a[4], bq[4]; u32x4 zr[4];
#pragma unroll
        for (int q = 0; q < 4; ++q) { const int m = min(m0 + q * nw, MTOK - 1); a[q] = *(const f32x4*)(OB + (size_t)m * 512 + lane * 8); bq[q] = *(const f32x4*)(OB + (size_t)m * 512 + lane * 8 + 4); zr[q] = *(const u32x4*)(ZGD + (size_t)m * 512 + lane * 8); }
        PIN();
#pragma unroll
        for (int q = 0; q < 4; ++q) {
            const int m = m0 + q * nw; if (m >= MTOK) break;
            float o[8] = {a[q][0], a[q][1], a[q][2], a[q][3], bq[q][0], bq[q][1], bq[q][2], bq[q][3]}, z[8];
            unpack8(zr[q], z);
            float ss = 0.f;
#pragma unroll
            for (int j = 0; j < 8; ++j) ss += o[j] * o[j];
            ss = row_sum16(ss);
            const float rs = rsqrtf(ss * (1.f / 128.f) + 1e-6f);
#pragma unroll
            for (int j = 0; j < 8; ++j) o[j] = o[j] * rs * onw[j] * z[j] * sigmoidf_(z[j]);
            *(u32x4*)(YB + (size_t)m * 512 + lane * 8) = pack8(o);
        }
    }
}
__device__ void phase6(const Params& p) {
    const float* rss = (const float*)(p.ws + OFF_RSS);
    const size_t stride = (size_t)gridDim.x * 512, total = (size_t)MTOK * 256;
    for (size_t i0 = (size_t)blockIdx.x * 512 + otid(); i0 < total; i0 += 4 * stride) {
        f32x4 v[4]; float sq[4];
#pragma unroll
        for (int q = 0; q < 4; ++q) { const size_t i = i0 + q * stride < total ? i0 + q * stride : i0; v[q] = *(const f32x4*)(p.out + i * 4); sq[q] = rss[i >> 8]; }
        PIN();
#pragma unroll
        for (int q = 0; q < 4; ++q) {
            const size_t i = i0 + q * stride; if (i >= total) break;
            const float rs = rsqrtf(sq[q] * (1.f / 1024.f) + 1e-6f); const f32x4 g = *(const f32x4*)(p.norm_out_w + (int)(i & 255) * 4);
            f32x4 o = v[q]; o[0] *= rs * g[0]; o[1] *= rs * g[1]; o[2] *= rs * g[2]; o[3] *= rs * g[3];
            *(f32x4*)(p.out + i * 4) = o;
        }
    }
}

#define XB_TMO      128
#define XB_XCNT(j)  (256  + 64 * (j))
#define XB_XSUB(j)  (1280 + 64 * (j))
#define XB_XGEN(j)  (2304 + 64 * (j))
#define XB_TOP      3328
#define XB_TOPGEN   3392
#define XCD_BAR_WORDS 3456
#define XB_SPIN_CAP (1u << 18)

__device__ __forceinline__ unsigned xb_ld(unsigned* p)              { return __hip_atomic_load(p, __ATOMIC_RELAXED, __HIP_MEMORY_SCOPE_AGENT); }
__device__ __forceinline__ unsigned xb_add(unsigned* p, unsigned v) { return __hip_atomic_fetch_add(p, v, __ATOMIC_RELAXED, __HIP_MEMORY_SCOPE_AGENT); }
__device__ __forceinline__ unsigned xb_xcc_id() { return (unsigned)__builtin_amdgcn_s_getreg((3 << 11) | 20) & 0xFu; }
#define XB_SPIN(cond, bar) do { unsigned _sp = 0; while (cond) { __builtin_amdgcn_s_sleep(1); \
    if ((++_sp & 255u) == 0u) { if (xb_ld(&(bar)[XB_TMO])) break; if (_sp > XB_SPIN_CAP) { atomicAdd(&(bar)[XB_TMO], 1u); break; } } } } while (0)

struct XcdBarrier {
    unsigned* bar; unsigned x;
    volatile LAS unsigned* st;
};

__device__ __forceinline__ XcdBarrier xcd_barrier_post(unsigned* bar, volatile LAS unsigned* st) {
    XcdBarrier b; b.bar = bar; b.x = xb_xcc_id(); b.st = st;
    if (threadIdx.x == 0) (void)xb_add(&bar[XB_XCNT(b.x)], 1u);
    return b;
}
__device__ __forceinline__ void xcd_barrier_complete(unsigned* bar, unsigned x, unsigned& nloc, unsigned& nx) {
    const unsigned G = gridDim.x * gridDim.y * gridDim.z;
    unsigned sum, cnt, mine, sp = 0u;
    for (;;) {
        sum = 0u; cnt = 0u; mine = 0u;
#pragma unroll
        for (unsigned j = 0; j < 16; ++j) { const unsigned c = xb_ld(&bar[XB_XCNT(j)]); sum += c; cnt += (c > 0u) ? 1u : 0u; mine = (j == x) ? c : mine; }
        if (sum == G) break;
        __builtin_amdgcn_s_sleep(1);
        if ((++sp & 255u) == 0u) { if (xb_ld(&bar[XB_TMO])) break; if (sp > XB_SPIN_CAP) { atomicAdd(&bar[XB_TMO], 1u); break; } }
    }
    nloc = mine > 0u ? mine : 1u; nx = cnt > 0u ? cnt : 1u;
}

__device__ __forceinline__ void xcd_barrier(const XcdBarrier& b) {
    asm volatile("s_waitcnt vmcnt(0)" ::: "memory");
    __syncthreads();
    if (threadIdx.x == 0) {
        unsigned* bar = b.bar;
        __builtin_amdgcn_s_waitcnt(0);
        unsigned nloc = b.st[0], nx = b.st[1];
        if (nloc == 0u) { xcd_barrier_complete(bar, b.x, nloc, nx); b.st[0] = nloc; b.st[1] = nx; }
        const unsigned old = xb_add(&bar[XB_XSUB(b.x)], 1u);
        const unsigned gen = old / nloc;
        if (old + 1u == (gen + 1u) * nloc) {
            __builtin_amdgcn_fence(__ATOMIC_RELEASE, "agent");
            asm volatile("s_waitcnt vmcnt(0)" ::: "memory");
            const unsigned og = xb_add(&bar[XB_TOP], 1u);
            const unsigned tg = og / nx;
            if (og + 1u == (tg + 1u) * nx) xb_add(&bar[XB_TOPGEN], 1u);
            else XB_SPIN(xb_ld(&bar[XB_TOPGEN]) == tg, bar);
            __builtin_amdgcn_fence(__ATOMIC_ACQUIRE, "agent");
            xb_add(&bar[XB_XGEN(b.x)], 1u);
            asm volatile("s_waitcnt vmcnt(0)" ::: "memory");
        } else {
            XB_SPIN(xb_ld(&bar[XB_XGEN(b.x)]) == gen, bar);
            __builtin_amdgcn_fence(__ATOMIC_ACQUIRE, "agent");
            asm volatile("s_waitcnt vmcnt(0)" ::: "memory");
        }
    }
    __syncthreads();
}


constexpr int NPHASE = 10;
template <int PH> __device__ __forceinline__ void run_phase(const Params& p, unsigned char* shm) {
    float* ldsf = (float*)shm;
    LAS unsigned char* lds3 = (LAS unsigned char*)shm;
    pg8::StaticOrder S;
    if constexpr (PH == 0) phase0(p, ldsf);
    if constexpr (PH == 1) { pg8::Gemm g{(const bf16_t*)(p.ws + OFF_H), (const bf16_t*)(p.ws + OFF_BTIN), MTOK, NPAD, 1024}; S.init(g.M, g.N, (int)gridDim.x, (int)blockIdx.x);
                  EpiIn E{p.ws, p.out}; pg8::gemm_phase(lds3, g, S, E);
                  {
                      const int G = (int)gridDim.x, c = (int)blockIdx.x, nu = (MTOK / 256) * (NPAD / 256), nmax = (nu + G - 1) / G, first_short = nu - (nmax - 1) * G;
                      int ns = G - first_short, rank = c - first_short; if (ns <= 0) { ns = G; rank = c; }
                      if (rank >= 0) later_weight_tiles(p, ldsf, rank, ns);
                  } }
    if constexpr (PH == 2) phase2(p);
    if constexpr (PH == 3) { pg8::Gemm g{(const bf16_t*)(p.ws + OFF_AP), (const bf16_t*)(p.ws + OFF_BTS), MTOK, 1024, 256}; S.init(g.M, g.N, (int)gridDim.x, (int)blockIdx.x);
                  EpiSmall E{p.ws}; pg8::gemm_phase(lds3, g, S, E); }
    if constexpr (PH == 4) { for (int t = blockIdx.x; t < 256; t += gridDim.x) { if (t < 128) rwkv_scan(p, ldsf, t); else gdn_scan(p, ldsf, t - 128); } }
    if constexpr (PH == 5) phase35(p);
    if constexpr (PH == 6) { pg8::Gemm g{(const bf16_t*)(p.ws + OFF_QKV), (const bf16_t*)(p.ws + OFF_BTA), MTOK, 1024, 1024, (const bf16_t*)(p.ws + OFF_AA), 512, 8}; S.init(g.M, g.N, (int)gridDim.x, (int)blockIdx.x);
                  EpiAB E{p.ws, p.out}; pg8::gemm_phase(lds3, g, S, E); }
    if constexpr (PH == 8) { pg8::Gemm g{(const bf16_t*)(p.ws + OFF_GQKV), (const bf16_t*)(p.ws + OFF_BTO), MTOK, 1024, 1024}; S.init(g.M, g.N, (int)gridDim.x, (int)blockIdx.x);
                  EpiC3 E{p.x, p.out, (float*)(p.ws + OFF_RSS)}; pg8::gemm_phase(lds3, g, S, E); }
    if constexpr (PH == 9) phase6(p);
}
template <int PH> __global__ __launch_bounds__(512) void fwd_phase(Params p) {
    extern __shared__ __attribute__((aligned(16))) unsigned char shm[];
    run_phase<PH>(p, shm);
}
#ifndef N_LAUNCH_MODE
#define N_LAUNCH_MODE 1
#endif
#ifndef REPEAT_MASK
#define REPEAT_MASK 0
#endif
#ifndef MEGA_MASK
#define MEGA_MASK 1023
#endif
#if N_LAUNCH_MODE == 1
__global__ __launch_bounds__(512) void fwd_mega(Params p) {
    extern __shared__ __attribute__((aligned(16))) unsigned char shm[];
    cg::grid_group grid = cg::this_grid();
    if (threadIdx.x < 4) ((unsigned*)(shm + LDS_BYTES - 16))[threadIdx.x] = 0u;
    __syncthreads();
    XcdBarrier xb = xcd_barrier_post((unsigned*)(p.ws + OFF_BAR), (volatile LAS unsigned*)(shm + LDS_BYTES - 16));
#if (MEGA_MASK >> 0) & 1
    run_phase<0>(p, shm);
#endif
#if (REPEAT_MASK >> 0) & 1
    xcd_barrier(xb); run_phase<0>(p, shm);
#endif
    xcd_barrier(xb);
#if (MEGA_MASK >> 1) & 1
    run_phase<1>(p, shm);
#endif
#if (REPEAT_MASK >> 1) & 1
    xcd_barrier(xb); run_phase<1>(p, shm);
#endif
    xcd_barrier(xb);
#if (MEGA_MASK >> 2) & 1
    run_phase<2>(p, shm);
#endif
#if (REPEAT_MASK >> 2) & 1
    xcd_barrier(xb); run_phase<2>(p, shm);
#endif
    xcd_barrier(xb);
#if (MEGA_MASK >> 3) & 1
    run_phase<3>(p, shm);
#endif
#if (REPEAT_MASK >> 3) & 1
    xcd_barrier(xb); run_phase<3>(p, shm);
#endif
    xcd_barrier(xb);
#if (MEGA_MASK >> 4) & 1
    run_phase<4>(p, shm);
#endif
#if (REPEAT_MASK >> 4) & 1
    xcd_barrier(xb); run_phase<4>(p, shm);
#endif
    grid.sync();
#if (MEGA_MASK >> 5) & 1
    run_phase<5>(p, shm);
#endif
#if (REPEAT_MASK >> 5) & 1
    xcd_barrier(xb); run_phase<5>(p, shm);
#endif
    xcd_barrier(xb);
#if (MEGA_MASK >> 6) & 1
    run_phase<6>(p, shm);
#endif
#if (REPEAT_MASK >> 6) & 1
    xcd_barrier(xb); run_phase<6>(p, shm);
#endif
    xcd_barrier(xb);
#if (MEGA_MASK >> 8) & 1
    run_phase<8>(p, shm);
#endif
#if (REPEAT_MASK >> 8) & 1
    xcd_barrier(xb); run_phase<8>(p, shm);
#endif
    xcd_barrier(xb);
#if (MEGA_MASK >> 9) & 1
    run_phase<9>(p, shm);
#endif
#if (REPEAT_MASK >> 9) & 1
    xcd_barrier(xb); run_phase<9>(p, shm);
#endif
}
#endif

#ifndef N_LAUNCH_MODE
#define N_LAUNCH_MODE 1
#endif
template <int... I> static void set_attrs(std::integer_sequence<int, I...>) { ((void)hipFuncSetAttribute((const void*)fwd_phase<I>, hipFuncAttributeMaxDynamicSharedMemorySize, LDS_BYTES), ...); }
template <int... I> static void launch_all(std::integer_sequence<int, I...>, const Params& p, int grid, hipStream_t stream) { ((fwd_phase<I><<<dim3(grid), dim3(512), LDS_BYTES, stream>>>(p)), ...); }
extern "C" void kernel_launch(void* const* d_in, const int* in_sizes, int n_in, void* d_out, int out_size, void* d_ws, size_t ws_size, hipStream_t stream) {
    static int grid = 0;
    if (grid == 0) {
        if (n_in != 21 || ws_size < WS_END) { fprintf(stderr, "kernel_launch: unexpected n_in %d / ws %zu (need %zu)\n", n_in, ws_size, (size_t)WS_END); grid = -1; return; }
        int dev = 0, cus = 0, per_cu = 0;
        (void)hipGetDevice(&dev); (void)hipDeviceGetAttribute(&cus, hipDeviceAttributeMultiprocessorCount, dev);
#if N_LAUNCH_MODE == 1
        (void)hipFuncSetAttribute((const void*)fwd_mega, hipFuncAttributeMaxDynamicSharedMemorySize, LDS_BYTES);
        (void)hipOccupancyMaxActiveBlocksPerMultiprocessor(&per_cu, (const void*)fwd_mega, 512, LDS_BYTES);
#else
        set_attrs(std::make_integer_sequence<int, NPHASE>{});
        per_cu = 1;
#endif
        if (per_cu < 1) per_cu = 1;
        grid = cus * per_cu;
        (void)hipGetLastError();
    }
    if (grid < 0) return;
    Params p{};
    const float** dst = (const float**)&p;
    for (int i = 0; i < 21; ++i) dst[i] = (const float*)d_in[i];
    p.out = (float*)d_out; p.ws = (unsigned char*)d_ws;
#if N_LAUNCH_MODE == 1
    (void)hipMemsetAsync((char*)d_ws + OFF_BAR, 0, 16384, stream);
    void* args[] = {&p};
    hipError_t e = hipLaunchCooperativeKernel((const void*)fwd_mega, dim3(grid), dim3(512), args, LDS_BYTES, stream);
    if (e != hipSuccess) fprintf(stderr, "cooperative launch failed: %s (grid %d)\n", hipGetErrorString(e), grid);
#else
    launch_all(std::make_integer_sequence<int, NPHASE>{}, p, grid, stream);
#endif
}
```
